# Optimizing an MI355X kernel written in HIP

```python
import jax, jax.numpy as jnp
from jax import lax
import numpy as np

D_MODEL = 1024
BATCH = 8
SEQ = 4096
DEPTH = 1

PLE_DIM = 256
POOL_GROUPS = 4
POOL_GROUP_DIM = 128
POOL_WINDOWS = (2, 4, 8, 16)
POOL_DIM = POOL_GROUPS * POOL_GROUP_DIM
N_HEADS = 8
N_KV_HEADS = 2
HEAD_DIM = 64
Q_GROUP = N_HEADS // N_KV_HEADS
Q_DIM = N_HEADS * HEAD_DIM
KV_DIM = N_KV_HEADS * HEAD_DIM
WINDOW = 128
ATTN_BLOCK = 128
IN_DIM = POOL_DIM + Q_DIM + 2 * KV_DIM
N_EXPERTS = 64
N_EXPERT_GROUPS = 8
TOPK_GROUPS = 4
TOP_K = 8
EXPERT_DIM = 256
SHARED_DIM = 256
ROUTED_SCALE = 2.5
MOE_BLOCK = 256
EPS = 1e-6

kernel_name = "hybrid_pool_swa_moe_block"


def rmsnorm(x, g):
    xf = x.astype(jnp.float32)
    xf = xf * lax.rsqrt(jnp.mean(xf * xf, axis=-1, keepdims=True) + EPS)
    return xf.astype(x.dtype) * g


def alibi_slopes(n_heads):
    return jnp.asarray(2.0 ** (-8.0 * (np.arange(n_heads) + 1) / n_heads), dtype=jnp.float32)


def pool_mixer(u, w_mix, scale):
    B, S, _ = u.shape
    uf = u.astype(jnp.float32).reshape(B, S, POOL_GROUPS, POOL_GROUP_DIM)
    cs = jnp.concatenate([jnp.zeros((B, 1, POOL_GROUPS, POOL_GROUP_DIM), jnp.float32),
                          jnp.cumsum(uf, axis=1)], axis=1)
    t = jnp.arange(S)
    outs = []
    for g, w in enumerate(POOL_WINDOWS):
        lo = jnp.maximum(t + 1 - w, 0)
        window_sum = cs[:, 1:, g] - cs[:, lo, g]
        count = jnp.minimum(t + 1, w).astype(jnp.float32)[None, :, None]
        outs.append(window_sum / count - uf[:, :, g])
    pooled = jnp.stack(outs, axis=2).astype(u.dtype)
    mixed = jnp.einsum('bsgc,gcd->bsgd', pooled, w_mix)
    return mixed.reshape(B, S, POOL_DIM) * scale


def swa_attention(q, k, v, q_gain, k_gain, sinks):
    B, S, _ = q.shape
    nb = S // ATTN_BLOCK
    q = rmsnorm(q.reshape(B, S, N_HEADS, HEAD_DIM), q_gain)
    k = rmsnorm(k.reshape(B, S, N_KV_HEADS, HEAD_DIM), k_gain)
    v = v.reshape(B, S, N_KV_HEADS, HEAD_DIM)
    qb = q.reshape(B, nb, ATTN_BLOCK, N_KV_HEADS, Q_GROUP, HEAD_DIM).astype(jnp.float32)

    def band(t):
        tb = t.reshape(B, nb, ATTN_BLOCK, N_KV_HEADS, HEAD_DIM)
        prev = jnp.concatenate([jnp.zeros_like(tb[:, :1]), tb[:, :-1]], axis=1)
        return jnp.concatenate([prev, tb], axis=2).astype(jnp.float32)

    kw, vw = band(k), band(v)
    scores = jnp.einsum('bnqkgd,bnskd->bnkgqs', qb, kw) * (HEAD_DIM ** -0.5)
    i = jnp.arange(ATTN_BLOCK)[:, None]
    j = jnp.arange(2 * ATTN_BLOCK)[None, :]
    dist = (ATTN_BLOCK + i - j)
    in_window = (dist >= 0) & (dist < WINDOW)
    key_exists = (jnp.arange(nb)[:, None] > 0) | (jnp.arange(2 * ATTN_BLOCK)[None, :] >= ATTN_BLOCK)
    mask = in_window[None] & key_exists[:, None, :]
    slopes = alibi_slopes(N_HEADS).reshape(N_KV_HEADS, Q_GROUP)
    scores = scores - slopes[:, :, None, None] * dist.astype(jnp.float32)
    scores = jnp.where(mask[None, :, None, None], scores, -jnp.inf)
    sink = sinks.astype(jnp.float32).reshape(N_KV_HEADS, Q_GROUP)[None, None, :, :, None, None]
    m = jnp.maximum(jnp.max(scores, axis=-1, keepdims=True), sink)
    e = jnp.exp(scores - m)
    probs = e / (jnp.sum(e, axis=-1, keepdims=True) + jnp.exp(sink - m))
    out = jnp.einsum('bnkgqs,bnskd->bnqkgd', probs, vw)
    return out.reshape(B, S, Q_DIM).astype(q.dtype)


def swiglu(x, wg, wu, wd):
    return (jax.nn.silu(x @ wg) * (x @ wu)) @ wd


def route(h, w_router, bias):
    T = h.shape[0]
    scores = jax.nn.sigmoid(h.astype(jnp.float32) @ w_router.astype(jnp.float32))
    choice = scores + bias.astype(jnp.float32)
    grp = choice.reshape(T, N_EXPERT_GROUPS, N_EXPERTS // N_EXPERT_GROUPS)
    grp_score = lax.top_k(grp, 2)[0].sum(-1)
    _, top_groups = lax.top_k(grp_score, TOPK_GROUPS)
    gmask = jax.nn.one_hot(top_groups, N_EXPERT_GROUPS, dtype=jnp.float32).sum(1) > 0
    emask = jnp.repeat(gmask, N_EXPERTS // N_EXPERT_GROUPS, axis=1)
    _, idx = lax.top_k(jnp.where(emask, choice, -jnp.inf), TOP_K)
    w = jnp.take_along_axis(scores, idx, axis=1)
    w = w / (jnp.sum(w, axis=-1, keepdims=True) + 1e-20) * ROUTED_SCALE
    return idx, w


def routed_experts(h, idx, w, w_gate, w_up, w_down):
    T, D = h.shape
    A = T * TOP_K
    e_flat = idx.reshape(A).astype(jnp.int32)
    tok_flat = (jnp.arange(A, dtype=jnp.int32) // TOP_K)
    w_flat = w.reshape(A)
    order = jnp.argsort(e_flat)
    e_sorted = e_flat[order]
    counts = jnp.bincount(e_flat, length=N_EXPERTS).astype(jnp.int32)
    start = jnp.cumsum(counts) - counts
    padded = (counts + MOE_BLOCK - 1) // MOE_BLOCK * MOE_BLOCK
    pend = jnp.cumsum(padded)
    pstart = pend - padded
    dest = pstart[e_sorted] + (jnp.arange(A, dtype=jnp.int32) - start[e_sorted])
    n_blocks = -(-A // MOE_BLOCK) + N_EXPERTS
    P = n_blocks * MOE_BLOCK
    tok_buf = jnp.full((P,), T, jnp.int32).at[dest].set(tok_flat[order])
    w_buf = jnp.zeros((P,), jnp.float32).at[dest].set(w_flat[order])
    block_e = jnp.minimum(jnp.searchsorted(pend, jnp.arange(n_blocks, dtype=jnp.int32) * MOE_BLOCK,
                                           side='right'), N_EXPERTS - 1)
    h_pad = jnp.concatenate([h, jnp.zeros((1, D), h.dtype)], axis=0)

    def body(acc, xs):
        tok, wt, e = xs
        y = swiglu(h_pad[tok], w_gate[e], w_up[e], w_down[e])
        return acc.at[tok].add(y.astype(jnp.float32) * wt[:, None]), None

    acc, _ = lax.scan(body, jnp.zeros((T + 1, D), jnp.float32),
                      (tok_buf.reshape(n_blocks, MOE_BLOCK), w_buf.reshape(n_blocks, MOE_BLOCK), block_e))
    return acc[:T].astype(h.dtype)


def setup_inputs(seed: int = 0) -> dict:
    key = jax.random.key(seed)
    ks = jax.random.split(key, 32)
    f32 = jnp.float32
    L, D = DEPTH, D_MODEL

    def nrm(k, shape, fan_in):
        return jax.random.normal(k, shape, f32) * (fan_in ** -0.5)

    def gain(k, shape):
        return 1.0 + 0.05 * jax.random.normal(k, shape, f32)

    return {
        "x": jax.random.normal(ks[0], (BATCH, SEQ, D), f32),
        "p": jax.random.normal(ks[1], (DEPTH, BATCH, SEQ, PLE_DIM), f32),
        "g_mix": gain(ks[2], (L, D)),
        "w_in": nrm(ks[3], (L, D, IN_DIM), D),
        "w_pool_mix": nrm(ks[4], (L, POOL_GROUPS, POOL_GROUP_DIM, POOL_GROUP_DIM), POOL_GROUP_DIM),
        "pool_scale": gain(ks[5], (L, POOL_DIM)),
        "w_branch_a": nrm(ks[6], (L, POOL_DIM, D), POOL_DIM),
        "q_gain": gain(ks[7], (L, HEAD_DIM)),
        "k_gain": gain(ks[8], (L, HEAD_DIM)),
        "attn_sinks": 0.5 * jax.random.normal(ks[9], (L, N_HEADS), f32),
        "w_branch_b": nrm(ks[10], (L, Q_DIM, D), Q_DIM),
        "w_gate": nrm(ks[11], (L, D, 2 * D), D),
        "b_gate": 0.1 * jax.random.normal(ks[12], (L, 2 * D), f32),
        "w_out": nrm(ks[13], (L, D, D), D),
        "g_ffn": gain(ks[14], (L, D)),
        "w_router": nrm(ks[15], (L, D, N_EXPERTS), D),
        "router_bias": 0.01 * jax.random.normal(ks[16], (L, N_EXPERTS), f32),
        "w_exp_gate": nrm(ks[17], (L, N_EXPERTS, D, EXPERT_DIM), D),
        "w_exp_up": nrm(ks[18], (L, N_EXPERTS, D, EXPERT_DIM), D),
        "w_exp_down": nrm(ks[19], (L, N_EXPERTS, EXPERT_DIM, D), EXPERT_DIM),
        "w_sh_gate": nrm(ks[20], (L, D, SHARED_DIM), D),
        "w_sh_up": nrm(ks[21], (L, D, SHARED_DIM), D),
        "w_sh_down": nrm(ks[22], (L, SHARED_DIM, D), SHARED_DIM),
        "g_ple": gain(ks[23], (L, D)),
        "w_ple_gate": nrm(ks[24], (L, D, D), D),
        "w_ple_proj": nrm(ks[25], (L, PLE_DIM, D), PLE_DIM),
        "g_ple_post": gain(ks[26], (L, D)),
    }


def reference(x, p, g_mix, w_in, w_pool_mix, pool_scale, w_branch_a, q_gain, k_gain, attn_sinks,
              w_branch_b, w_gate, b_gate, w_out, g_ffn, w_router, router_bias, w_exp_gate, w_exp_up,
              w_exp_down, w_sh_gate, w_sh_up, w_sh_down, g_ple, w_ple_gate, w_ple_proj, g_ple_post):
    B, S, D = x.shape
    T = B * S
    for i in range(DEPTH):
        h = rmsnorm(x, g_mix[i])
        u = h @ w_in[i]
        u_pool = u[..., :POOL_DIM]
        q = u[..., POOL_DIM:POOL_DIM + Q_DIM]
        k = u[..., POOL_DIM + Q_DIM:POOL_DIM + Q_DIM + KV_DIM]
        v = u[..., POOL_DIM + Q_DIM + KV_DIM:]
        y_a = pool_mixer(u_pool, w_pool_mix[i], pool_scale[i]) @ w_branch_a[i]
        y_b = swa_attention(q, k, v, q_gain[i], k_gain[i], attn_sinks[i]) @ w_branch_b[i]
        gates = jax.nn.sigmoid(h @ w_gate[i] + b_gate[i])
        merged = gates[..., :D] * y_a + gates[..., D:] * y_b
        x = x + merged @ w_out[i]
        h2 = rmsnorm(x, g_ffn[i]).reshape(T, D)
        idx, wts = route(h2, w_router[i], router_bias[i])
        moe = routed_experts(h2, idx, wts, w_exp_gate[i], w_exp_up[i], w_exp_down[i]) \
            + swiglu(h2, w_sh_gate[i], w_sh_up[i], w_sh_down[i])
        x = x + moe.reshape(B, S, D)
        ple_gate = jax.nn.sigmoid(rmsnorm(x, g_ple[i]) @ w_ple_gate[i])
        x = x + ple_gate * rmsnorm(p[i] @ w_ple_proj[i], g_ple_post[i])
    return x
```

```cpp
#include <hip/hip_runtime.h>
#include <cstdio>
#include <cstdint>

namespace nv {
constexpr int T = 32768, D = 1024, SEQ = 4096, PLE = 256;
constexpr int POOLD = 512, QD = 512, KVD = 128, IND = 1280;
constexpr int NE = 64, TOPK = 8, ED = 256, SD = 256;
constexpr float EPS = 1e-6f;

__device__ __forceinline__ float wave_sum(float v) {
#pragma unroll
    for (int o = 1; o < 64; o <<= 1) v += __shfl_xor(v, o);
    return v;
}
__device__ __forceinline__ float wave_max(float v) {
#pragma unroll
    for (int o = 1; o < 64; o <<= 1) v = fmaxf(v, __shfl_xor(v, o));
    return v;
}
__device__ __forceinline__ float sigmoidf(float x) { return 1.f / (1.f + expf(-x)); }
__device__ __forceinline__ float siluf(float x) { return x / (1.f + expf(-x)); }

__global__ void __launch_bounds__(256) rmsnorm_rows(const float* x, const float* __restrict__ g, float* out, int nrows, int ncol) {
    const int lane = threadIdx.x & 63, w = (blockIdx.x * 256 + threadIdx.x) >> 6;
    if (w >= nrows) return;
    const float* xr = x + (size_t)w * ncol; float* orow = out + (size_t)w * ncol;
    float ss = 0.f;
    for (int c = lane; c < ncol; c += 64) { const float v = xr[c]; ss += v * v; }
    ss = wave_sum(ss);
    const float r = rsqrtf(ss / (float)ncol + EPS);
    for (int c = lane; c < ncol; c += 64) orow[c] = xr[c] * r * g[c];
}

template <class ARow>
__device__ __forceinline__ void gemm_tile(ARow arow, const float* __restrict__ B, int ldb, int K, int n0, float (&acc)[4][4], float (*As)[68], float (*Bs)[64]) {
    const int tid = threadIdx.x, tx = tid & 15, ty = tid >> 4;
#pragma unroll
    for (int i = 0; i < 4; ++i)
#pragma unroll
        for (int j = 0; j < 4; ++j) acc[i][j] = 0.f;
    const int ar = tid >> 2, ak = (tid & 3) * 4;
    const float* ap = arow(ar);
    const int bk = tid >> 4, bn = (tid & 15) * 4;
    for (int k0 = 0; k0 < K; k0 += 16) {
        const float4 av = *(const float4*)(ap + k0 + ak);
        const float4 bv = *(const float4*)(B + (size_t)(k0 + bk) * ldb + n0 + bn);
        __syncthreads();
        As[ak + 0][ar] = av.x; As[ak + 1][ar] = av.y; As[ak + 2][ar] = av.z; As[ak + 3][ar] = av.w;
        *(float4*)&Bs[bk][bn] = bv;
        __syncthreads();
#pragma unroll
        for (int kk = 0; kk < 16; ++kk) {
            const float4 a = *(const float4*)&As[kk][ty * 4];
            const float4 b = *(const float4*)&Bs[kk][tx * 4];
            const float aa[4] = {a.x, a.y, a.z, a.w}, bb[4] = {b.x, b.y, b.z, b.w};
#pragma unroll
            for (int i = 0; i < 4; ++i)
#pragma unroll
                for (int j = 0; j < 4; ++j) acc[i][j] += aa[i] * bb[j];
        }
    }
}
struct RowPtr { const float* base; int ld; __device__ __forceinline__ const float* operator()(int r) const { return base + (size_t)r * ld; } };

template <int MODE>
__global__ void __launch_bounds__(256) gemm_plain(const float* __restrict__ A, int lda, const float* __restrict__ B, int ldb, float* __restrict__ C, int ldc, int K,
                                                   const float* __restrict__ scale, int zA, int zB, int zC) {
    __shared__ __attribute__((aligned(16))) float As[16][68];
    __shared__ __attribute__((aligned(16))) float Bs[16][64];
    const int z = blockIdx.z; A += (size_t)z * zA; B += (size_t)z * zB; C += (size_t)z * zC; if (MODE == 1) scale += (size_t)z * zC;
    const int m0 = blockIdx.y * 64, n0 = blockIdx.x * 64, tx = threadIdx.x & 15, ty = threadIdx.x >> 4;
    float acc[4][4];
    gemm_tile(RowPtr{A + (size_t)m0 * lda, lda}, B, ldb, K, n0, acc, As, Bs);
#pragma unroll
    for (int i = 0; i < 4; ++i)
#pragma unroll
        for (int j = 0; j < 4; ++j) { const int n = n0 + tx * 4 + j; float v = acc[i][j]; if (MODE == 1) v *= scale[n]; C[(size_t)(m0 + ty * 4 + i) * ldc + n] = v; }
}

__global__ void __launch_bounds__(256) pool_kernel(const float* __restrict__ u, float* __restrict__ pooled) {
    const size_t i = (size_t)blockIdx.x * 256 + threadIdx.x;
    const int t = (int)(i >> 9), c = (int)(i & 511), g = c >> 7, w = 2 << g, pos = t % SEQ;
    const int cnt = pos + 1 < w ? pos + 1 : w;
    float s = 0.f;
    for (int k = 0; k < cnt; ++k) s += u[(size_t)(t - k) * IND + c];
    pooled[i] = s / (float)cnt - u[(size_t)t * IND + c];
}

__global__ void __launch_bounds__(256) qknorm_kernel(float* __restrict__ u, const float* __restrict__ qg, const float* __restrict__ kg) {
    const int lane = threadIdx.x & 63, t = (blockIdx.x * 256 + threadIdx.x) >> 6;
    float* row = u + (size_t)t * IND + POOLD;
#pragma unroll
    for (int j = 0; j < 10; ++j) {
        const float v = row[j * 64 + lane];
        const float ss = wave_sum(v * v);
        row[j * 64 + lane] = v * rsqrtf(ss * (1.f / 64.f) + EPS) * (j < 8 ? qg[lane] : kg[lane]);
    }
}

__global__ void __launch_bounds__(256) attn_kernel(const float* __restrict__ u, const float* __restrict__ sinks, float* __restrict__ attn) {
    const int lane = threadIdx.x & 63, wv = (blockIdx.x * 256 + threadIdx.x) >> 6;
    const int t = wv >> 3, h = wv & 7, kv = h >> 2, pos = t % SEQ;
    const float slope = exp2f(-(float)(h + 1)), sink = sinks[h];
    const float qv = u[(size_t)t * IND + POOLD + h * 64 + lane];
    float sc[2];
#pragma unroll
    for (int half = 0; half < 2; ++half) {
        const int dist = half * 64 + lane;
        const bool valid = pos - dist >= 0;
        const float* kr = u + (size_t)(valid ? t - dist : t) * IND + POOLD + QD + kv * 64;
        float d = 0.f;
        for (int dd = 0; dd < 64; ++dd) d += __shfl(qv, dd) * kr[dd];
        sc[half] = valid ? d * 0.125f - slope * (float)dist : -INFINITY;
    }
    float m = fmaxf(wave_max(fmaxf(sc[0], sc[1])), sink);
    const float e0 = (pos - lane >= 0) ? expf(sc[0] - m) : 0.f, e1 = (pos - 64 - lane >= 0) ? expf(sc[1] - m) : 0.f;
    const float denom = wave_sum(e0 + e1) + expf(sink - m);
    float o = 0.f;
    for (int j = 0; j < 128; ++j) {
        const float p = __shfl(j < 64 ? e0 : e1, j & 63);
        if (pos - j >= 0) o += p * u[(size_t)(t - j) * IND + POOLD + QD + KVD + kv * 64 + lane];
    }
    attn[(size_t)t * QD + h * 64 + lane] = o / denom;
}

__global__ void __launch_bounds__(256) merged_kernel(const float* __restrict__ h, const float* __restrict__ mixed, const float* __restrict__ attn, const float* __restrict__ Wa,
                                                      const float* __restrict__ Wb, const float* __restrict__ Wg, const float* __restrict__ bg, float* __restrict__ merged) {
    __shared__ __attribute__((aligned(16))) float As[16][68];
    __shared__ __attribute__((aligned(16))) float Bs[16][64];
    const int m0 = blockIdx.y * 64, n0 = blockIdx.x * 64, tx = threadIdx.x & 15, ty = threadIdx.x >> 4;
    float ya[4][4], yb[4][4], za[4][4], zb[4][4];
    gemm_tile(RowPtr{mixed + (size_t)m0 * POOLD, POOLD}, Wa, D, POOLD, n0, ya, As, Bs);
    gemm_tile(RowPtr{attn + (size_t)m0 * QD, QD}, Wb, D, QD, n0, yb, As, Bs);
    gemm_tile(RowPtr{h + (size_t)m0 * D, D}, Wg, 2 * D, D, n0, za, As, Bs);
    gemm_tile(RowPtr{h + (size_t)m0 * D, D}, Wg, 2 * D, D, D + n0, zb, As, Bs);
#pragma unroll
    for (int i = 0; i < 4; ++i)
#pragma unroll
        for (int j = 0; j < 4; ++j) { const int n = n0 + tx * 4 + j;
            merged[(size_t)(m0 + ty * 4 + i) * D + n] = sigmoidf(za[i][j] + bg[n]) * ya[i][j] + sigmoidf(zb[i][j] + bg[D + n]) * yb[i][j]; }
}

__global__ void __launch_bounds__(256) gemm_resid(const float* __restrict__ A, int lda, const float* __restrict__ B, int ldb, const float* base, float* out, int ldc, int K) {
    __shared__ __attribute__((aligned(16))) float As[16][68];
    __shared__ __attribute__((aligned(16))) float Bs[16][64];
    const int m0 = blockIdx.y * 64, n0 = blockIdx.x * 64, tx = threadIdx.x & 15, ty = threadIdx.x >> 4;
    float acc[4][4];
    gemm_tile(RowPtr{A + (size_t)m0 * lda, lda}, B, ldb, K, n0, acc, As, Bs);
#pragma unroll
    for (int i = 0; i < 4; ++i)
#pragma unroll
        for (int j = 0; j < 4; ++j) { const size_t o = (size_t)(m0 + ty * 4 + i) * ldc + n0 + tx * 4 + j; out[o] = base[o] + acc[i][j]; }
}

__global__ void __launch_bounds__(256) swiglu_up(const float* __restrict__ A, const float* __restrict__ Wg, const float* __restrict__ Wu, float* __restrict__ act) {
    __shared__ __attribute__((aligned(16))) float As[16][68];
    __shared__ __attribute__((aligned(16))) float Bs[16][64];
    const int m0 = blockIdx.y * 64, n0 = blockIdx.x * 64, tx = threadIdx.x & 15, ty = threadIdx.x >> 4;
    float g[4][4], uu[4][4];
    gemm_tile(RowPtr{A + (size_t)m0 * D, D}, Wg, SD, D, n0, g, As, Bs);
    gemm_tile(RowPtr{A + (size_t)m0 * D, D}, Wu, SD, D, n0, uu, As, Bs);
#pragma unroll
    for (int i = 0; i < 4; ++i)
#pragma unroll
        for (int j = 0; j < 4; ++j) act[(size_t)(m0 + ty * 4 + i) * SD + n0 + tx * 4 + j] = siluf(g[i][j]) * uu[i][j];
}

__global__ void __launch_bounds__(64) route_kernel(const float* __restrict__ logits, const float* __restrict__ bias, int* __restrict__ cnt, int* __restrict__ list, float* __restrict__ wts) {
    __shared__ float S[64][65];
    __shared__ float C[64][65];
    const int lane = threadIdx.x, t = blockIdx.x * 64 + lane;
    for (int e = 0; e < 64; ++e) { const float s = sigmoidf(logits[(size_t)t * 64 + e]); S[lane][e] = s; C[lane][e] = s + bias[e]; }
    float gs[8];
#pragma unroll
    for (int g = 0; g < 8; ++g) { float m1 = -INFINITY, m2 = -INFINITY;
#pragma unroll
        for (int j = 0; j < 8; ++j) { const float v = C[lane][g * 8 + j]; if (v > m1) { m2 = m1; m1 = v; } else if (v > m2) m2 = v; }
        gs[g] = m1 + m2; }
    unsigned gsel = 0u;
#pragma unroll
    for (int it = 0; it < 4; ++it) { float best = -INFINITY; int bi = 0;
#pragma unroll
        for (int g = 0; g < 8; ++g) { const bool free_ = !((gsel >> g) & 1u); if (free_ && gs[g] > best) { best = gs[g]; bi = g; } }
        gsel |= 1u << bi; }
    unsigned long long chosen = 0ull; float wsum = 0.f; int idx[8]; float wv[8];
#pragma unroll
    for (int k = 0; k < 8; ++k) { float best = -INFINITY; int bi = 0;
        for (int e = 0; e < 64; ++e) { const bool ok = ((gsel >> (e >> 3)) & 1u) && !((chosen >> e) & 1ull); const float v = C[lane][e]; if (ok && v > best) { best = v; bi = e; } }
        chosen |= 1ull << bi; idx[k] = bi; wv[k] = S[lane][bi]; wsum += wv[k]; }
#pragma unroll
    for (int k = 0; k < 8; ++k) { const float w = wv[k] / (wsum + 1e-20f) * 2.5f; wts[(size_t)t * 8 + k] = w;
        const int p = atomicAdd(&cnt[idx[k]], 1); list[(size_t)idx[k] * T + p] = t * 8 + k; }
}

struct GatherRow { const float* h2; const int* lst; int nvalid; __device__ __forceinline__ const float* operator()(int r) const { return h2 + (size_t)(r < nvalid ? (lst[r] >> 3) : 0) * D; } };
__global__ void __launch_bounds__(256) routed_up(const float* __restrict__ h2, const float* __restrict__ Wg, const float* __restrict__ Wu, const int* __restrict__ cnt, const int* __restrict__ list, float* __restrict__ act) {
    __shared__ __attribute__((aligned(16))) float As[16][68];
    __shared__ __attribute__((aligned(16))) float Bs[16][64];
    const int e = blockIdx.z, r0 = blockIdx.y * 64, n = cnt[e];
    if (r0 >= n) return;
    const int n0 = blockIdx.x * 64, tx = threadIdx.x & 15, ty = threadIdx.x >> 4;
    const int* lst = list + (size_t)e * T + r0; const int nvalid = n - r0;
    float g[4][4], uu[4][4];
    gemm_tile(GatherRow{h2, lst, nvalid}, Wg + (size_t)e * D * ED, ED, D, n0, g, As, Bs);
    gemm_tile(GatherRow{h2, lst, nvalid}, Wu + (size_t)e * D * ED, ED, D, n0, uu, As, Bs);
#pragma unroll
    for (int i = 0; i < 4; ++i) { const int r = ty * 4 + i; if (r < nvalid) { const int a = lst[r];
#pragma unroll
        for (int j = 0; j < 4; ++j) act[(size_t)a * ED + n0 + tx * 4 + j] = siluf(g[i][j]) * uu[i][j]; } }
}
struct ActRow { const float* act; const int* lst; int nvalid; __device__ __forceinline__ const float* operator()(int r) const { return act + (size_t)(r < nvalid ? lst[r] : lst[0]) * ED; } };
__global__ void __launch_bounds__(256) routed_down(const float* __restrict__ act, const float* __restrict__ Wd, const int* __restrict__ cnt, const int* __restrict__ list, const float* __restrict__ wts, float* __restrict__ out) {
    __shared__ __attribute__((aligned(16))) float As[16][68];
    __shared__ __attribute__((aligned(16))) float Bs[16][64];
    const int e = blockIdx.z, r0 = blockIdx.y * 64, n = cnt[e];
    if (r0 >= n) return;
    const int n0 = blockIdx.x * 64, tx = threadIdx.x & 15, ty = threadIdx.x >> 4;
    const int* lst = list + (size_t)e * T + r0; const int nvalid = n - r0;
    float acc[4][4];
    gemm_tile(ActRow{act, lst, nvalid}, Wd + (size_t)e * ED * D, D, ED, n0, acc, As, Bs);
#pragma unroll
    for (int i = 0; i < 4; ++i) { const int r = ty * 4 + i; if (r < nvalid) { const int a = lst[r]; const float w = wts[a]; float* orow = out + (size_t)(a >> 3) * D + n0 + tx * 4;
#pragma unroll
        for (int j = 0; j < 4; ++j) atomicAdd(orow + j, w * acc[i][j]); } }
}

__global__ void __launch_bounds__(256) ple_final(const float* __restrict__ h3, const float* __restrict__ Wpg, const float* __restrict__ ppn, float* out) {
    __shared__ __attribute__((aligned(16))) float As[16][68];
    __shared__ __attribute__((aligned(16))) float Bs[16][64];
    const int m0 = blockIdx.y * 64, n0 = blockIdx.x * 64, tx = threadIdx.x & 15, ty = threadIdx.x >> 4;
    float acc[4][4];
    gemm_tile(RowPtr{h3 + (size_t)m0 * D, D}, Wpg, D, D, n0, acc, As, Bs);
#pragma unroll
    for (int i = 0; i < 4; ++i)
#pragma unroll
        for (int j = 0; j < 4; ++j) { const size_t o = (size_t)(m0 + ty * 4 + i) * D + n0 + tx * 4 + j; out[o] = out[o] + sigmoidf(acc[i][j]) * ppn[o]; }
}
}

extern "C" void kernel_launch(void* const* d_in, const int* in_sizes, int n_in, void* d_out, int out_size, void* d_ws, size_t ws_size, hipStream_t stream) {
    using namespace nv;
    const float* x = (const float*)d_in[0]; const float* p = (const float*)d_in[1]; const float* g_mix = (const float*)d_in[2]; const float* w_in = (const float*)d_in[3];
    const float* w_pool_mix = (const float*)d_in[4]; const float* pool_scale = (const float*)d_in[5]; const float* w_a = (const float*)d_in[6]; const float* q_gain = (const float*)d_in[7];
    const float* k_gain = (const float*)d_in[8]; const float* sinks = (const float*)d_in[9]; const float* w_b = (const float*)d_in[10]; const float* w_gate = (const float*)d_in[11];
    const float* b_gate = (const float*)d_in[12]; const float* w_out = (const float*)d_in[13]; const float* g_ffn = (const float*)d_in[14]; const float* w_router = (const float*)d_in[15];
    const float* router_bias = (const float*)d_in[16]; const float* w_eg = (const float*)d_in[17]; const float* w_eu = (const float*)d_in[18]; const float* w_ed = (const float*)d_in[19];
    const float* w_sg = (const float*)d_in[20]; const float* w_su = (const float*)d_in[21]; const float* w_sd = (const float*)d_in[22]; const float* g_ple = (const float*)d_in[23];
    const float* w_pg = (const float*)d_in[24]; const float* w_pp = (const float*)d_in[25]; const float* g_post = (const float*)d_in[26];
    float* out = (float*)d_out;
    char* ws = (char*)d_ws; const size_t MiB = 1u << 20;
    float* h = (float*)(ws);
    float* u = (float*)(ws + 128 * MiB);
    float* pooled = (float*)(ws + 288 * MiB);
    float* mixed = (float*)(ws + 352 * MiB);
    float* attn = (float*)(ws + 416 * MiB);
    float* logits = (float*)(ws + 480 * MiB);
    float* wts = (float*)(ws + 488 * MiB);
    int* list = (int*)(ws + 490 * MiB);
    int* cnt = (int*)(ws + 498 * MiB);
    if (ws_size < 499 * MiB) { fprintf(stderr, "ws too small\n"); return; }

    rmsnorm_rows<<<T / 4, 256, 0, stream>>>(x, g_mix, h, T, D);
    gemm_plain<0><<<dim3(IND / 64, T / 64, 1), 256, 0, stream>>>(h, D, w_in, IND, u, IND, D, nullptr, 0, 0, 0);
    pool_kernel<<<T * 512 / 256, 256, 0, stream>>>(u, pooled);
    gemm_plain<1><<<dim3(2, T / 64, 4), 256, 0, stream>>>(pooled, POOLD, w_pool_mix, 128, mixed, POOLD, 128, pool_scale, 128, 128 * 128, 128);
    qknorm_kernel<<<T / 4, 256, 0, stream>>>(u, q_gain, k_gain);
    attn_kernel<<<T * 8 / 4, 256, 0, stream>>>(u, sinks, attn);
    float* merged = u;
    merged_kernel<<<dim3(D / 64, T / 64), 256, 0, stream>>>(h, mixed, attn, w_a, w_b, w_gate, b_gate, merged);
    gemm_resid<<<dim3(D / 64, T / 64), 256, 0, stream>>>(merged, D, w_out, D, x, out, D, D);
    rmsnorm_rows<<<T / 4, 256, 0, stream>>>(out, g_ffn, h, T, D);
    gemm_plain<0><<<dim3(1, T / 64, 1), 256, 0, stream>>>(h, D, w_router, NE, logits, NE, D, nullptr, 0, 0, 0);
    hipMemsetAsync(cnt, 0, 64 * sizeof(int), stream);
    route_kernel<<<T / 64, 64, 0, stream>>>(logits, router_bias, cnt, list, wts);
    float* act_sh = pooled;
    swiglu_up<<<dim3(SD / 64, T / 64), 256, 0, stream>>>(h, w_sg, w_su, act_sh);
    gemm_resid<<<dim3(D / 64, T / 64), 256, 0, stream>>>(act_sh, SD, w_sd, D, out, out, D, SD);
    float* act_r = u;
    routed_up<<<dim3(ED / 64, T / 64, NE), 256, 0, stream>>>(h, w_eg, w_eu, cnt, list, act_r);
    routed_down<<<dim3(D / 64, T / 64, NE), 256, 0, stream>>>(act_r, w_ed, cnt, list, wts, out);
    rmsnorm_rows<<<T / 4, 256, 0, stream>>>(out, g_ple, h, T, D);
    float* pp = u;
    gemm_plain<0><<<dim3(D / 64, T / 64, 1), 256, 0, stream>>>(p, PLE, w_pp, D, pp, D, PLE, nullptr, 0, 0, 0);
    rmsnorm_rows<<<T / 4, 256, 0, stream>>>(pp, g_post, pp, T, D);
    ple_final<<<dim3(D / 64, T / 64), 256, 0, stream>>>(h, w_pg, pp, out);
}
```

```cpp
#include <hip/hip_runtime.h>
#include <hip/hip_cooperative_groups.h>
#include <cstdio>
#include <cstdint>
namespace cg = cooperative_groups;

#define LAS __attribute__((address_space(3)))
typedef unsigned short bf16_t;
typedef short bf16x8 __attribute__((ext_vector_type(8)));
typedef float f32x4 __attribute__((ext_vector_type(4)));
typedef unsigned u32x4 __attribute__((ext_vector_type(4)));
typedef unsigned u32x2 __attribute__((ext_vector_type(2)));
typedef float f32x2 __attribute__((ext_vector_type(2)));

namespace mk {
constexpr int T = 32768, D = 1024, SEQ = 4096, PLE = 256;
constexpr int POOLD = 512, QD = 512, KVD = 128, IND = 1280, NCAT = 3328;
constexpr int NE = 64, ED = 256, SD = 256;
constexpr float EPS = 1e-6f;
constexpr float LOG2E = 1.4426950408889634f;
constexpr int NT = 512;
constexpr size_t MiB = 1u << 20;
constexpr size_t W_CAT = 0;
constexpr size_t W_PP = W_CAT + (size_t)NCAT * D * 2;
constexpr size_t W_MIX = W_PP + (size_t)D * PLE * 2;
constexpr size_t W_A = W_MIX + 2 * 256 * 256 * 2;
constexpr size_t W_B = W_A + (size_t)D * 512 * 2;
constexpr size_t W_OUT = W_B + (size_t)D * 512 * 2;
constexpr size_t W_SH = W_OUT + (size_t)D * D * 2;
constexpr size_t W_R = W_SH + (size_t)512 * D * 2;
constexpr size_t W_SD = W_R + (size_t)256 * D * 2;
constexpr size_t W_PG = W_SD + (size_t)D * 256 * 2;
constexpr size_t W_EXP = 16 * MiB;
constexpr size_t W_ED = 80 * MiB;
static_assert(W_PG + (size_t)D * D * 2 <= W_EXP, "weights map");
constexpr size_t CTL = 112 * MiB;
constexpr size_t C_RSPP = CTL, C_RS2 = CTL + 128 * 1024, C_RS3 = CTL + 256 * 1024;
constexpr size_t C_CNTBLK = CTL + 512 * 1024;
constexpr size_t C_SEL = CTL + 2 * MiB;
constexpr size_t C_TOKL = CTL + 3 * MiB;
constexpr size_t C_RINFO = CTL + 4 * MiB + 512 * 1024;
constexpr size_t YB = 184 * MiB;
constexpr size_t ACTSH = 464 * MiB;
constexpr int NCHUNK = T / 128;
constexpr size_t C_BAR = CTL + 7 * MiB + 512 * 1024;
constexpr int NROUND = 4, TR = T / NROUND;
constexpr int LT_LO = 4096, LT_TST = LT_LO + (NROUND + 1) * 64 * 4, LT_T2E7 = LT_TST + NROUND * 65 * 4, LT_T2E8 = LT_T2E7 + 1152;
constexpr int T2S = TR * 8 / 256 + 64;
static_assert(LT_T2E8 + NROUND * T2S <= 16384 && TR / 128 * NROUND == T / 128, "LDS tables");
constexpr int LDS_TAB = 131072;
constexpr size_t C_WTS = CTL + 1 * MiB;
constexpr size_t PP = 120 * MiB;
constexpr size_t HB = 184 * MiB;
constexpr size_t PB = 248 * MiB;
constexpr size_t UB = 264 * MiB;
constexpr size_t GB = 344 * MiB;
constexpr size_t POOLB = 472 * MiB;
constexpr size_t LOGITS = 504 * MiB;
constexpr size_t ACTR = 328 * MiB;

__device__ __forceinline__ int lane_id() { int l; asm volatile("v_mbcnt_lo_u32_b32 %0, -1, 0\n\tv_mbcnt_hi_u32_b32 %0, -1, %0" : "=v"(l)); return l; }
__device__ __forceinline__ float bf2f(unsigned v) { return __uint_as_float(v << 16); }
__device__ __forceinline__ unsigned f2bf(float f) { unsigned u = __float_as_uint(f); return (u + 0x7fffu + ((u >> 16) & 1u)) >> 16; }
__device__ __forceinline__ unsigned cvt_pk_bf16(float lo, float hi) { unsigned r; asm volatile("v_cvt_pk_bf16_f32 %0, %1, %2" : "=v"(r) : "v"(lo), "v"(hi)); return r; }
__device__ __forceinline__ unsigned pk2(float lo, float hi) { return f2bf(lo) | (f2bf(hi) << 16); }
__device__ __forceinline__ float wave_sum(float v) {
#pragma unroll
    for (int o = 1; o < 64; o <<= 1) v += __shfl_xor(v, o);
    return v;
}
__device__ __forceinline__ float wave_max(float v) {
#pragma unroll
    for (int o = 1; o < 64; o <<= 1) v = fmaxf(v, __shfl_xor(v, o));
    return v;
}
__device__ __forceinline__ float sigmoidf(float x) { return __builtin_amdgcn_rcpf(1.f + __builtin_amdgcn_exp2f(-x * LOG2E)); }
__device__ __forceinline__ float siluf(float x) { return x * sigmoidf(x); }
}

namespace pg8 {
constexpr int BM = 256, BK = 64, HALF = 128, HTB = HALF * BK * 2, STAGE_BYTES = 8 * HTB, NXCD = 8, WGM = 8;
__host__ __device__ __forceinline__ int lds_byte(int r, int c) { const int st = (r >> 4) * 2 + (c >> 5), rr = r & 15, cc = c & 31, ob = rr * 64 + cc * 2; return st * 1024 + (ob ^ (((ob >> 9) & 1) << 5)); }
__host__ __device__ __forceinline__ void stage_rc(int b, int& R, int& C) { const int st = b / 1024, sb = b % 1024, swz = sb ^ (((sb >> 9) & 1) << 5); R = (st >> 1) * 16 + swz / 64; C = (st & 1) * 32 + (swz % 64) / 2; }
__host__ __device__ __forceinline__ int perm32(int rho) { const int n = rho >> 4, i = rho & 15; return 8 * (i >> 2) + 4 * n + (i & 3); }

struct Unit { int pm, pn; const char* A; const char* B; int tag; int r0, rend; };
__device__ __forceinline__ const char* uni_ptr(const char* p) { const unsigned long long v = (unsigned long long)p; const unsigned lo = __builtin_amdgcn_readfirstlane((unsigned)v), hi = __builtin_amdgcn_readfirstlane((unsigned)(v >> 32)); return (const char*)(((unsigned long long)hi << 32) | lo); }
struct Cfg { unsigned lda, ldb; int K; };

__device__ __forceinline__ bool static_tile(int i, int G, int c, int nM, int nN, int& pm, int& pn) {
    const int nwg = nM * nN; const long L = (long)i * G + c; if (L >= nwg) return false;
    int wgid = (int)L; { const int q = nwg / NXCD, r = nwg % NXCD, xcd = wgid % NXCD, off = wgid / NXCD; wgid = (xcd < r ? xcd * (q + 1) : r * (q + 1) + (xcd - r) * q) + off; }
    const int nig = WGM * nN, gid = wgid / nig, fm = gid * WGM, gsz = (nM - fm) < WGM ? (nM - fm) : WGM;
    pm = fm + ((wgid % nig) % gsz); pn = (wgid % nig) / gsz; return true;
}
struct DenseSched {
    int nM, nN, G, c; const char* A; const char* B; size_t tA, tB;
    __device__ __forceinline__ bool next(int i, Unit& u) const { if (!static_tile(i, G, c, nM, nN, u.pm, u.pn)) return false; u.A = A + (size_t)u.pm * tA; u.B = B + (size_t)u.pn * tB; u.tag = 0; return true; }
    __device__ __forceinline__ int row(const Unit&, int r) const { return r; }
};

template <class Epi, class Sched, bool GATHER>
__device__ __forceinline__ void gemm_phase(LAS unsigned char* lds, const Cfg g, const Sched& S, const Epi& E, int wv_) {
    int tid_ = wv_ * 64 + mk::lane_id(); asm volatile("" : "+v"(tid_));
    const int tid = tid_, wid = __builtin_amdgcn_readfirstlane(tid >> 6), lane = tid & 63, wr = wid >> 2, wc = wid & 3, fr = lane & 15, fq = lane >> 4;
    const int nt = g.K / BK;
    int RA[2], CA2[2]; unsigned vB[2], vAc[2][2], vAn[2][2];
#pragma unroll
    for (int i = 0; i < 2; ++i) { int R, C; stage_rc(tid * 16 + i * 8192, R, C); const int Rb = Epi::PERM ? (64 * (R >> 5) + 16 * ((R & 15) >> 2) + 4 * ((R >> 4) & 1) + (R & 3)) : R;
        RA[i] = R; CA2[i] = C * 2; vB[i] = (unsigned)Rb * g.ldb + (unsigned)C * 2u; }
    const size_t kstep = (size_t)(BK * 2);
    const size_t hB = (size_t)(Epi::PERM ? 8 : HALF) * g.ldb;
    const unsigned ldsw = (unsigned)wid * 1024u;
    const int aoff = lds_byte(wr * 64 + fr, fq * 8), boff = lds_byte(wc * 32 + fr, fq * 8);
#define PG8_SA(b, h) (((b) * 2 + (h)) * HTB)
#define PG8_SB(b, h) ((4 + (b) * 2 + (h)) * HTB)
#define PG8_STAGE(bufoff, gbase, voff) do { const char* _gb = uni_ptr((const char*)(gbase)); _Pragma("unroll") for (int _i = 0; _i < 2; ++_i) \
        __builtin_amdgcn_global_load_lds((const unsigned*)(_gb + (voff)[_i]), (LAS unsigned*)(lds + (bufoff) + ldsw + _i * 8192), 16, 0, 0); } while (0)
#define PG8_LDA(dst, b, h) do { _Pragma("unroll") for (int m = 0; m < 4; ++m) _Pragma("unroll") for (int k = 0; k < 2; ++k) dst[m][k] = *(const LAS bf16x8*)(lds + PG8_SA(b, h) + aoff + m * 2048 + k * 1024); } while (0)
#define PG8_LDB(dst, b, h) do { _Pragma("unroll") for (int n = 0; n < 2; ++n) _Pragma("unroll") for (int k = 0; k < 2; ++k) dst[n][k] = *(const LAS bf16x8*)(lds + PG8_SB(b, h) + boff + n * 2048 + k * 1024); } while (0)
#define PG8_MMA(ai, bj, At, Bt) do { __builtin_amdgcn_s_setprio(1); _Pragma("unroll") for (int m = 0; m < 4; ++m) _Pragma("unroll") for (int n = 0; n < 2; ++n) _Pragma("unroll") for (int k = 0; k < 2; ++k) \
        acc[ai][bj][m][n] = __builtin_amdgcn_mfma_f32_16x16x32_bf16(Bt[n][k], At[m][k], acc[ai][bj][m][n], 0, 0, 0); __builtin_amdgcn_s_setprio(0); } while (0)
#define PG8_WAIT_V(n) asm volatile("s_waitcnt vmcnt(" #n ")" ::: "memory")
#define PG8_WAIT_L(n) asm volatile("s_waitcnt lgkmcnt(" #n ")" ::: "memory")
#define PG8_BAR __builtin_amdgcn_s_barrier()
#define PG8_SCHED __builtin_amdgcn_sched_barrier(0)
#define PG8_VOFF(dst, u) do { _Pragma("unroll") for (int _h = 0; _h < 2; ++_h) _Pragma("unroll") for (int _i = 0; _i < 2; ++_i) \
        dst[_h][_i] = (unsigned)S.row(u, _h * HALF + RA[_i]) * g.lda + (unsigned)CA2[_i]; } while (0)
    Unit cur, nxt; int ui = 0;
    if (!S.next(0, cur)) return;
    f32x4 acc[2][2][4][2];
#pragma unroll
    for (int a = 0; a < 2; ++a)
#pragma unroll
        for (int b = 0; b < 2; ++b)
#pragma unroll
            for (int m = 0; m < 4; ++m)
#pragma unroll
                for (int n = 0; n < 2; ++n) acc[a][b][m][n] = (f32x4){0.f, 0.f, 0.f, 0.f};
    bf16x8 At[4][2], B0[2][2], B1[2][2];
    const char* cA = uni_ptr(cur.A); const char* cB = uni_ptr(cur.B);
    PG8_VOFF(vAc, cur);
    PG8_STAGE(PG8_SB(0, 0), cB, vB); PG8_STAGE(PG8_SB(0, 1), cB + hB, vB); PG8_STAGE(PG8_SA(0, 0), cA, vAc[0]); PG8_STAGE(PG8_SA(0, 1), cA, vAc[1]);
    if (wr == 1) PG8_BAR;
    PG8_WAIT_V(2); PG8_BAR;
    PG8_STAGE(PG8_SB(1, 0), cB + kstep, vB); PG8_STAGE(PG8_SA(1, 0), cA + kstep, vAc[0]); PG8_STAGE(PG8_SB(1, 1), cB + hB + kstep, vB);
    PG8_WAIT_V(6); PG8_BAR;
    for (;;) {
        const bool has_next = S.next(ui + 1, nxt);
        const char* nA = uni_ptr(has_next ? nxt.A : cA); const char* nB = uni_ptr(has_next ? nxt.B : cB);
        if constexpr (GATHER) { if (has_next) { PG8_VOFF(vAn, nxt); } else {
#pragma unroll
            for (int _h = 0; _h < 2; ++_h)
#pragma unroll
                for (int _i = 0; _i < 2; ++_i) vAn[_h][_i] = vAc[_h][_i]; } }
        for (int t = 0; t < nt; t += 2) {
            const bool last = (t == nt - 2);
            asm volatile("" : "+v"(vB[0]), "+v"(vB[1]), "+v"(vAc[0][0]), "+v"(vAc[0][1]), "+v"(vAc[1][0]), "+v"(vAc[1][1]));
            const char* a1 = cA + (size_t)(t + 1) * kstep;
            const char* a2 = uni_ptr(last ? nA : cA + (size_t)(t + 2) * kstep); const char* b2 = uni_ptr(last ? nB : cB + (size_t)(t + 2) * kstep);
            const char* a3 = a2 + kstep; const char* b3 = b2 + kstep;
            unsigned w0[2], w1[2];
#pragma unroll
            for (int _i = 0; _i < 2; ++_i) { if constexpr (GATHER) { w0[_i] = last ? vAn[0][_i] : vAc[0][_i]; w1[_i] = last ? vAn[1][_i] : vAc[1][_i]; } else { w0[_i] = vAc[0][_i]; w1[_i] = vAc[1][_i]; } }
            PG8_LDB(B0, 0, 0); PG8_LDB(B1, 0, 1); PG8_SCHED; PG8_LDA(At, 0, 0); PG8_STAGE(PG8_SA(1, 1), a1, vAc[1]);
            PG8_WAIT_V(8); PG8_WAIT_L(0); PG8_BAR; PG8_MMA(0, 0, At, B0); PG8_MMA(0, 1, At, B1); PG8_BAR; PG8_SCHED;
            PG8_LDA(At, 0, 1); PG8_STAGE(PG8_SB(0, 0), b2, vB); PG8_STAGE(PG8_SB(0, 1), b2 + hB, vB); PG8_STAGE(PG8_SA(0, 0), a2, w0);
            PG8_WAIT_V(8); PG8_WAIT_L(0); PG8_BAR; PG8_MMA(1, 0, At, B0); PG8_MMA(1, 1, At, B1); PG8_BAR; PG8_SCHED;
            PG8_LDB(B0, 1, 0); PG8_LDB(B1, 1, 1); PG8_SCHED; PG8_LDA(At, 1, 0); PG8_STAGE(PG8_SA(0, 1), a2, w1);
            PG8_WAIT_V(8); PG8_WAIT_L(0); PG8_BAR; PG8_MMA(0, 0, At, B0); PG8_MMA(0, 1, At, B1); PG8_BAR; PG8_SCHED;
            PG8_LDA(At, 1, 1); PG8_STAGE(PG8_SB(1, 0), b3, vB); PG8_STAGE(PG8_SB(1, 1), b3 + hB, vB); PG8_STAGE(PG8_SA(1, 0), a3, w0);
            PG8_WAIT_V(8); PG8_WAIT_L(0); PG8_BAR; PG8_MMA(1, 0, At, B0); PG8_MMA(1, 1, At, B1); PG8_BAR; PG8_SCHED;
        }
        if (wr == 0) PG8_BAR;
        const bool keep = E(acc, cur, wr, wc, fr, fq);
        if (!has_next) break;
        if (!keep) {
#pragma unroll
            for (int a = 0; a < 2; ++a)
#pragma unroll
                for (int b = 0; b < 2; ++b)
#pragma unroll
                    for (int m = 0; m < 4; ++m)
#pragma unroll
                        for (int n = 0; n < 2; ++n) acc[a][b][m][n] = (f32x4){0.f, 0.f, 0.f, 0.f};
        }
        cur = nxt; cA = nA; cB = nB; ++ui;
        if constexpr (GATHER) {
#pragma unroll
            for (int _h = 0; _h < 2; ++_h)
#pragma unroll
                for (int _i = 0; _i < 2; ++_i) vAc[_h][_i] = vAn[_h][_i]; }
        if (wr == 1) PG8_BAR;
    }
    PG8_WAIT_V(0);
    PG8_BAR;
#undef PG8_SA
#undef PG8_SB
#undef PG8_STAGE
#undef PG8_LDA
#undef PG8_LDB
#undef PG8_MMA
#undef PG8_WAIT_V
#undef PG8_WAIT_L
#undef PG8_BAR
#undef PG8_SCHED
#undef PG8_VOFF
}
}

namespace mk {
struct P {
    const float *x, *p, *g_mix, *w_in, *w_pool_mix, *pool_scale, *w_a, *q_gain, *k_gain, *sinks, *w_b, *w_gate, *b_gate, *w_out, *g_ffn, *w_router, *router_bias,
                *w_eg, *w_eu, *w_ed, *w_sg, *w_su, *w_sd, *g_ple, *w_pg, *w_pp, *g_post;
    float* out; char* ws;
};

struct RowBf { const bf16_t* base; int ld; __device__ __forceinline__ float4 load4(int r, int k) const { const uint2 v = *(const uint2*)(base + (size_t)r * ld + k);
    return make_float4(bf2f(v.x & 0xffffu), bf2f(v.x >> 16), bf2f(v.y & 0xffffu), bf2f(v.y >> 16)); } };
struct RowBfIdx { const bf16_t* base; int ld; const int* lst; int nvalid; int shift;
    __device__ __forceinline__ float4 load4(int r, int k) const { const int row = (r < nvalid ? lst[r] : lst[0]) >> shift; const uint2 v = *(const uint2*)(base + (size_t)row * ld + k);
    return make_float4(bf2f(v.x & 0xffffu), bf2f(v.x >> 16), bf2f(v.y & 0xffffu), bf2f(v.y >> 16)); } };
template <class ARow>
__device__ __forceinline__ void gemm_tile(int vt, ARow arow, const float* __restrict__ B, int ldb, int K, int n0, float (&acc)[4][4], float (*As)[68], float (*Bs)[64]) {
    const int tx = vt & 15, ty = vt >> 4;
#pragma unroll
    for (int i = 0; i < 4; ++i)
#pragma unroll
        for (int j = 0; j < 4; ++j) acc[i][j] = 0.f;
    const int ar = vt >> 2, ak = (vt & 3) * 4;
    const int bk = vt >> 4, bn = (vt & 15) * 4;
#pragma unroll 1
    for (int k0 = 0; k0 < K; k0 += 16) {
        const float4 av = arow.load4(ar, k0 + ak);
        const float4 bv = *(const float4*)(B + (size_t)(k0 + bk) * ldb + n0 + bn);
        __syncthreads();
        As[ak + 0][ar] = av.x; As[ak + 1][ar] = av.y; As[ak + 2][ar] = av.z; As[ak + 3][ar] = av.w;
        *(float4*)&Bs[bk][bn] = bv;
        __syncthreads();
#pragma unroll
        for (int kk = 0; kk < 16; ++kk) {
            const float4 a = *(const float4*)&As[kk][ty * 4];
            const float4 b = *(const float4*)&Bs[kk][tx * 4];
            const float aa[4] = {a.x, a.y, a.z, a.w}, bb[4] = {b.x, b.y, b.z, b.w};
#pragma unroll
            for (int i = 0; i < 4; ++i)
#pragma unroll
                for (int j = 0; j < 4; ++j) acc[i][j] += aa[i] * bb[j];
        }
    }
}
#define VB_LOOP(nvb) for (int _it = 0, _nit = ((nvb) + 2 * (int)gridDim.x - 1) / (2 * (int)gridDim.x); _it < _nit; ++_it) { \
    const int _raw = _it * 2 * (int)gridDim.x + (int)blockIdx.x * 2 + half; const bool vvalid = _raw < (nvb); const int vb = vvalid ? _raw : 0;
#define VB_END }
#define FOR_IJ _Pragma("unroll") for (int i = 0; i < 4; ++i) _Pragma("unroll") for (int j = 0; j < 4; ++j)

struct TItem { const float* src; int ld; bf16_t* dst; int ldk; const float* ks; int gu; };
__device__ __forceinline__ TItem ti_plain(const float* W, int K, int N, bf16_t* dstm, int row_off, int item, const float* kscale = nullptr) {
    const int nblk = N / 32, kb = item / nblk, nb = item % nblk;
    return TItem{W + (size_t)(64 * kb) * N + 32 * nb, N, dstm + (size_t)(row_off + 32 * nb) * K + 64 * kb, K, kscale ? kscale + 64 * kb : nullptr, 0}; }
__device__ __forceinline__ TItem ti_gu(const float* W, bf16_t* dstm, int up, int item, const float* kscale) {
    const int kb = item / 8, nb = item % 8, c0 = 32 * nb;
    return TItem{W + (size_t)(64 * kb) * 256 + c0, 256, dstm + (size_t)((c0 >> 7) * 256 + 2 * (c0 & 127) + 8 * up) * 1024 + 64 * kb, 1024, kscale + 64 * kb, 1}; }
__device__ __forceinline__ TItem ti_gate(const float* W, bf16_t* wcat, int item) {
    const int kb = item / 64, nb = item % 64, c0 = 32 * nb, ab = c0 >> 10, oc = c0 & 1023;
    return TItem{W + (size_t)(64 * kb) * (2 * D) + c0, 2 * D, wcat + (size_t)(IND + 256 * (oc >> 7) + 2 * (oc & 127) + 8 * ab) * D + 64 * kb, D, nullptr, 1}; }
__device__ __forceinline__ void ti_load(const TItem& t, f32x4 (&v)[8], int lane) {
#pragma unroll
    for (int i = 0; i < 8; ++i) { v[i] = *(const f32x4*)(t.src + (size_t)(8 * (lane >> 3) + i) * t.ld + 4 * (lane & 7)); if (t.ks) v[i] = v[i] * t.ks[8 * (lane >> 3) + i]; } }
__device__ __forceinline__ void ti_finish(const TItem& t, const f32x4 (&v)[8], LAS float*, int lane) {
#pragma unroll
    for (int j = 0; j < 4; ++j) { u32x4 o; o.x = pk2(v[0][j], v[1][j]); o.y = pk2(v[2][j], v[3][j]); o.z = pk2(v[4][j], v[5][j]); o.w = pk2(v[6][j], v[7][j]);
        const int n_ = 4 * (lane & 7) + j; *(u32x4*)(t.dst + (size_t)(t.gu ? 2 * (n_ & ~7) + (n_ & 7) : n_) * t.ldk + 8 * (lane >> 3)) = o; }
}

struct EpiG1 {
    static constexpr bool PERM = true;
    bf16_t* u; bf16_t* gates; const float* bg;
    __device__ __forceinline__ bool operator()(f32x4 (&acc)[2][2][4][2], const pg8::Unit& un, int wr, int wc, int fr, int fq) const {
        const int row0 = un.pm * 256 + wr * 64 + fr;
        if (un.pn < 5) { const int col0 = un.pn * 256 + wc * 64 + 16 * fq;
#pragma unroll
            for (int ai = 0; ai < 2; ++ai)
#pragma unroll
                for (int m = 0; m < 4; ++m) { bf16_t* rowp = u + (size_t)(row0 + ai * 128 + m * 16) * IND + col0;
#pragma unroll
                    for (int bj = 0; bj < 2; ++bj) { const f32x4 v0 = acc[ai][bj][m][0], v1 = acc[ai][bj][m][1];
                        u32x4 w; w.x = cvt_pk_bf16(v0[0], v0[1]); w.y = cvt_pk_bf16(v0[2], v0[3]); w.z = cvt_pk_bf16(v1[0], v1[1]); w.w = cvt_pk_bf16(v1[2], v1[3]);
                        *(u32x4*)(rowp + bj * 8) = w; } }
        } else { const int c0 = (un.pn - 5) * 128 + wc * 32 + 8 * fq;
            const f32x4 ba0 = *(const f32x4*)(bg + c0), ba1 = *(const f32x4*)(bg + c0 + 4), bb0 = *(const f32x4*)(bg + D + c0), bb1 = *(const f32x4*)(bg + D + c0 + 4);
#pragma unroll
            for (int ai = 0; ai < 2; ++ai)
#pragma unroll
                for (int m = 0; m < 4; ++m) { bf16_t* rowp = gates + (size_t)(row0 + ai * 128 + m * 16) * 2 * D + c0;
                    const f32x4 za0 = acc[ai][0][m][0] + ba0, za1 = acc[ai][0][m][1] + ba1, zb0 = acc[ai][1][m][0] + bb0, zb1 = acc[ai][1][m][1] + bb1;
                    f32x4 r0, r1, g0, g1;
#pragma unroll
                    for (int q = 0; q < 4; ++q) { g0[q] = sigmoidf(zb0[q]); g1[q] = sigmoidf(zb1[q]);
                        r0[q] = sigmoidf(za0[q]) * __builtin_amdgcn_rcpf(fmaxf(g0[q], 1e-12f)); r1[q] = sigmoidf(za1[q]) * __builtin_amdgcn_rcpf(fmaxf(g1[q], 1e-12f)); }
                    u32x4 w; w.x = cvt_pk_bf16(r0[0], r0[1]); w.y = cvt_pk_bf16(r0[2], r0[3]); w.z = cvt_pk_bf16(r1[0], r1[1]); w.w = cvt_pk_bf16(r1[2], r1[3]);
                    *(u32x4*)rowp = w;
                    w.x = cvt_pk_bf16(g0[0], g0[1]); w.y = cvt_pk_bf16(g0[2], g0[3]); w.z = cvt_pk_bf16(g1[0], g1[1]); w.w = cvt_pk_bf16(g1[2], g1[3]);
                    *(u32x4*)(rowp + D) = w; } }
        return false;
    }
};
struct EpiPP {
    static constexpr bool PERM = true;
    bf16_t* pp; float* rss;
    __device__ __forceinline__ bool operator()(f32x4 (&acc)[2][2][4][2], const pg8::Unit& un, int wr, int wc, int fr, int fq) const {
        const int row0 = un.pm * 256 + wr * 64 + fr, col0 = un.pn * 256 + wc * 64 + 16 * fq;
#pragma unroll
        for (int ai = 0; ai < 2; ++ai)
#pragma unroll
            for (int m = 0; m < 4; ++m) { const int row = row0 + ai * 128 + m * 16; bf16_t* rowp = pp + (size_t)row * D + col0; float s = 0.f;
#pragma unroll
                for (int bj = 0; bj < 2; ++bj) { const f32x4 v0 = acc[ai][bj][m][0], v1 = acc[ai][bj][m][1];
                    s += (v0[0] * v0[0] + v0[1] * v0[1]) + (v0[2] * v0[2] + v0[3] * v0[3]) + (v1[0] * v1[0] + v1[1] * v1[1]) + (v1[2] * v1[2] + v1[3] * v1[3]);
                    u32x4 w; w.x = cvt_pk_bf16(v0[0], v0[1]); w.y = cvt_pk_bf16(v0[2], v0[3]); w.z = cvt_pk_bf16(v1[0], v1[1]); w.w = cvt_pk_bf16(v1[2], v1[3]);
                    *(u32x4*)(rowp + bj * 8) = w; }
                s += __shfl_xor(s, 16); s += __shfl_xor(s, 32);
                if (fq == 0) atomicAdd(rss + row, s); }
        return false;
    }
};


struct EpiBf16Plain {
    static constexpr bool PERM = true;
    bf16_t* O; int ld;
    __device__ __forceinline__ bool operator()(f32x4 (&acc)[2][2][4][2], const pg8::Unit& un, int wr, int wc, int fr, int fq) const {
        const int row0 = un.pm * 256 + wr * 64 + fr, col0 = un.pn * 256 + wc * 64 + 16 * fq;
#pragma unroll
        for (int ai = 0; ai < 2; ++ai)
#pragma unroll
            for (int m = 0; m < 4; ++m) { bf16_t* rowp = O + (size_t)(row0 + ai * 128 + m * 16) * ld + col0;
#pragma unroll
                for (int bj = 0; bj < 2; ++bj) { const f32x4 v0 = acc[ai][bj][m][0], v1 = acc[ai][bj][m][1];
                    u32x4 w; w.x = cvt_pk_bf16(v0[0], v0[1]); w.y = cvt_pk_bf16(v0[2], v0[3]); w.z = cvt_pk_bf16(v1[0], v1[1]); w.w = cvt_pk_bf16(v1[2], v1[3]);
                    *(u32x4*)(rowp + bj * 8) = w; } }
        return false;
    }
};
struct PPSched {
    int G, c; const char* A; const char* B;
    __device__ __forceinline__ bool next(int i, pg8::Unit& u) const {
        if (G != 256) { if (!pg8::static_tile(i, G, c, T / 256, D / 256, u.pm, u.pn)) return false; }
        else { int idx; if (c < 128) { if (i > 0) return false; idx = c; } else { if (i > 2) return false; idx = 128 + (c - 128) * 3 + i; } u.pm = idx >> 2; u.pn = idx & 3; }
        u.A = A + (size_t)u.pm * 256 * PLE * 2; u.B = B + (size_t)u.pn * 256 * PLE * 2; u.tag = 0; return true; }
    __device__ __forceinline__ int row(const pg8::Unit&, int r) const { return r; }
};
struct P6Sched {
    int G, c; const char* A; const char* B;
    __device__ __forceinline__ bool next(int i, pg8::Unit& u) const {
        if (G != 256) { if (!pg8::static_tile(i, G, c, T / 256, 3, u.pm, u.pn)) return false; }
        else if (c < 128) { if (i > 0) return false; u.pm = c; u.pn = 2; }
        else { if (i > 1) return false; const int idx = (c - 128) * 2 + i; u.pm = idx >> 1; u.pn = idx & 1; }
        u.A = A + (size_t)u.pm * 256 * D * 2; u.B = B + (size_t)u.pn * 256 * D * 2; u.tag = 0; return true; }
    __device__ __forceinline__ int row(const pg8::Unit&, int r) const { return r; }
};
struct MixSched {
    int G, c; const char* A; const char* B;
    __device__ __forceinline__ bool next(int i, pg8::Unit& u) const { if (!pg8::static_tile(i, G, c, T / 256, 2, u.pm, u.pn)) return false;
        u.A = A + (size_t)u.pm * 256 * POOLD * 2 + (size_t)u.pn * 512; u.B = B + (size_t)u.pn * 256 * 256 * 2; u.tag = 0; return true; }
    __device__ __forceinline__ int row(const pg8::Unit&, int r) const { return r; }
};
struct MergedSched {
    int G, c; const char* A0; const char* A1; const char* B0; const char* B1;
    __device__ __forceinline__ bool next(int i, pg8::Unit& u) const { if (!pg8::static_tile(i >> 1, G, c, T / 256, D / 256, u.pm, u.pn)) return false;
        const int br = i & 1; u.A = (br ? A1 : A0) + (size_t)u.pm * 256 * 512 * 2; u.B = (br ? B1 : B0) + (size_t)u.pn * 256 * 512 * 2; u.tag = br; return true; }
    __device__ __forceinline__ int row(const pg8::Unit&, int r) const { return r; }
};
struct EpiMerged {
    static constexpr bool PERM = true;
    const bf16_t* gates; bf16_t* O;
    __device__ __forceinline__ bool operator()(f32x4 (&acc)[2][2][4][2], const pg8::Unit& un, int wr, int wc, int fr, int fq) const {
        const int row0 = un.pm * 256 + wr * 64 + fr, col0 = un.pn * 256 + wc * 64 + 16 * fq;
#pragma unroll
        for (int ai = 0; ai < 2; ++ai)
#pragma unroll
            for (int m = 0; m < 4; ++m) { const size_t row = (size_t)(row0 + ai * 128 + m * 16);
#pragma unroll
                for (int bj = 0; bj < 2; ++bj) { const u32x4 gv = *(const u32x4*)(gates + row * 2 * D + (un.tag == 0 ? 0 : D) + col0 + bj * 8);
                    const float gf[8] = {bf2f(gv.x & 0xffffu), bf2f(gv.x >> 16), bf2f(gv.y & 0xffffu), bf2f(gv.y >> 16), bf2f(gv.z & 0xffffu), bf2f(gv.z >> 16), bf2f(gv.w & 0xffffu), bf2f(gv.w >> 16)};
                    if (un.tag == 0) {
#pragma unroll
                        for (int q = 0; q < 4; ++q) { acc[ai][bj][m][0][q] *= gf[q]; acc[ai][bj][m][1][q] *= gf[4 + q]; }
                    } else { const f32x4 v0 = acc[ai][bj][m][0], v1 = acc[ai][bj][m][1];
                        u32x4 w; w.x = cvt_pk_bf16(v0[0] * gf[0], v0[1] * gf[1]); w.y = cvt_pk_bf16(v0[2] * gf[2], v0[3] * gf[3]); w.z = cvt_pk_bf16(v1[0] * gf[4], v1[1] * gf[5]); w.w = cvt_pk_bf16(v1[2] * gf[6], v1[3] * gf[7]);
                        *(u32x4*)(O + row * D + col0 + bj * 8) = w; } } }
        return un.tag == 0;
    }
};
struct EpiResid {
    static constexpr bool PERM = true;
    const float* x; bf16_t* xb; float* rss;
    __device__ __forceinline__ bool operator()(f32x4 (&acc)[2][2][4][2], const pg8::Unit& un, int wr, int wc, int fr, int fq) const {
        const int row0 = un.pm * 256 + wr * 64 + fr, col0 = un.pn * 256 + wc * 64 + 16 * fq;
#pragma unroll
        for (int ai = 0; ai < 2; ++ai)
#pragma unroll
            for (int m = 0; m < 4; ++m) { const int row = row0 + ai * 128 + m * 16; const size_t off = (size_t)row * D + col0; float s = 0.f;
#pragma unroll
                for (int bj = 0; bj < 2; ++bj) { const f32x4 v0 = *(const f32x4*)(x + off + bj * 8) + acc[ai][bj][m][0], v1 = *(const f32x4*)(x + off + bj * 8 + 4) + acc[ai][bj][m][1];
                    s += (v0[0] * v0[0] + v0[1] * v0[1]) + (v0[2] * v0[2] + v0[3] * v0[3]) + (v1[0] * v1[0] + v1[1] * v1[1]) + (v1[2] * v1[2] + v1[3] * v1[3]);
                    u32x4 w; w.x = cvt_pk_bf16(v0[0], v0[1]); w.y = cvt_pk_bf16(v0[2], v0[3]); w.z = cvt_pk_bf16(v1[0], v1[1]); w.w = cvt_pk_bf16(v1[2], v1[3]);
                    *(u32x4*)(xb + off + bj * 8) = w; }
                s += __shfl_xor(s, 16); s += __shfl_xor(s, 32);
                if (fq == 0) atomicAdd(rss + row, s); }
        return false;
    }
};
struct EpiShared {
    static constexpr bool PERM = true;
    bf16_t* act; float* lg; const float* rss;
    __device__ __forceinline__ bool operator()(f32x4 (&acc)[2][2][4][2], const pg8::Unit& un, int wr, int wc, int fr, int fq) const {
        const int row0 = un.pm * 256 + wr * 64 + fr;
#pragma unroll
        for (int ai = 0; ai < 2; ++ai)
#pragma unroll
            for (int m = 0; m < 4; ++m) { const int row = row0 + ai * 128 + m * 16; const float rs = rsqrtf(rss[row] * (1.f / D) + EPS);
                if (un.pn < 2) { const f32x4 g0 = acc[ai][0][m][0] * rs, g1 = acc[ai][0][m][1] * rs, u0 = acc[ai][1][m][0] * rs, u1 = acc[ai][1][m][1] * rs;
                    u32x4 w; w.x = cvt_pk_bf16(siluf(g0[0]) * u0[0], siluf(g0[1]) * u0[1]); w.y = cvt_pk_bf16(siluf(g0[2]) * u0[2], siluf(g0[3]) * u0[3]);
                    w.z = cvt_pk_bf16(siluf(g1[0]) * u1[0], siluf(g1[1]) * u1[1]); w.w = cvt_pk_bf16(siluf(g1[2]) * u1[2], siluf(g1[3]) * u1[3]);
                    *(u32x4*)(act + (size_t)row * SD + un.pn * 128 + wc * 32 + 8 * fq) = w;
                } else if (wc == 0) { float* lp = lg + (size_t)row * NE + 16 * fq;
                    *(f32x4*)lp = acc[ai][0][m][0] * rs; *(f32x4*)(lp + 4) = acc[ai][0][m][1] * rs; *(f32x4*)(lp + 8) = acc[ai][1][m][0] * rs; *(f32x4*)(lp + 12) = acc[ai][1][m][1] * rs; } }
        return false;
    }
};
struct EpiFinal {
    static constexpr bool PERM = true;
    float* o; const bf16_t* x2; const bf16_t* pp; const float* rss3_; const float* rsspp_; const float* gp;
    __device__ __forceinline__ bool operator()(f32x4 (&acc)[2][2][4][2], const pg8::Unit& un, int wr, int wc, int fr, int fq) const {
        const int row0 = un.pm * 256 + wr * 64 + fr, col0 = un.pn * 256 + wc * 64 + 16 * fq;
        f32x4 gv[2][2];
#pragma unroll
        for (int bj = 0; bj < 2; ++bj)
#pragma unroll
            for (int n = 0; n < 2; ++n) gv[bj][n] = *(const f32x4*)(gp + col0 + bj * 8 + n * 4);
#pragma unroll
        for (int ai = 0; ai < 2; ++ai)
#pragma unroll
            for (int m = 0; m < 4; ++m) { const int row = row0 + ai * 128 + m * 16; const size_t off = (size_t)row * D + col0;
                const float r3 = rsqrtf(rss3_[row] * (1.f / D) + EPS), rp = rsqrtf(rsspp_[row] * (1.f / D) + EPS);
#pragma unroll
                for (int bj = 0; bj < 2; ++bj) { const size_t o2 = off + bj * 8; const u32x4 xv = *(const u32x4*)(x2 + o2), pv = *(const u32x4*)(pp + o2);
                    const f32x4 a0 = acc[ai][bj][m][0] * r3, a1 = acc[ai][bj][m][1] * r3; f32x4 v0, v1;
                    v0[0] = bf2f(xv.x & 0xffffu) + sigmoidf(a0[0]) * bf2f(pv.x & 0xffffu) * rp * gv[bj][0][0]; v0[1] = bf2f(xv.x >> 16) + sigmoidf(a0[1]) * bf2f(pv.x >> 16) * rp * gv[bj][0][1];
                    v0[2] = bf2f(xv.y & 0xffffu) + sigmoidf(a0[2]) * bf2f(pv.y & 0xffffu) * rp * gv[bj][0][2]; v0[3] = bf2f(xv.y >> 16) + sigmoidf(a0[3]) * bf2f(pv.y >> 16) * rp * gv[bj][0][3];
                    v1[0] = bf2f(xv.z & 0xffffu) + sigmoidf(a1[0]) * bf2f(pv.z & 0xffffu) * rp * gv[bj][1][0]; v1[1] = bf2f(xv.z >> 16) + sigmoidf(a1[1]) * bf2f(pv.z >> 16) * rp * gv[bj][1][1];
                    v1[2] = bf2f(xv.w & 0xffffu) + sigmoidf(a1[2]) * bf2f(pv.w & 0xffffu) * rp * gv[bj][1][2]; v1[3] = bf2f(xv.w >> 16) + sigmoidf(a1[3]) * bf2f(pv.w >> 16) * rp * gv[bj][1][3];
                    *(f32x4*)(o + o2) = v0; *(f32x4*)(o + o2 + 4) = v1; } }
        return false;
    }
};
__device__ __forceinline__ int find_expert(const LAS int* mts, int mt) { int e = 0;
#pragma unroll 1
    for (; e < NE - 1; ++e) if (mt < mts[e + 1]) break;
    return e; }
struct RoutedUpSched {
    int G, c, nM; const LAS unsigned char* t2e; const int* tl; const char* A; const char* B;
    __device__ __forceinline__ bool next(int i, pg8::Unit& u) const { if (!pg8::static_tile(i, G, c, nM, 2, u.pm, u.pn)) return false;
        const int e = t2e[u.pm]; u.A = A; u.B = B + (size_t)e * 512 * D * 2 + (size_t)u.pn * 256 * D * 2; u.tag = e; return true; }
    __device__ __forceinline__ int row(const pg8::Unit& u, int r) const { const int aid = tl[u.pm * 256 + r]; return aid < 0 ? 0 : (aid >> 3); }
};
struct EpiRoutedUp {
    static constexpr bool PERM = true;
    bf16_t* act; const int2* ri; const float* wt;
    __device__ __forceinline__ bool operator()(f32x4 (&acc)[2][2][4][2], const pg8::Unit& un, int wr, int wc, int fr, int fq) const {
        const int row0 = un.pm * 256 + wr * 64 + fr;
#pragma unroll
        for (int ai = 0; ai < 2; ++ai)
#pragma unroll
            for (int m = 0; m < 4; ++m) { const int pos = row0 + ai * 128 + m * 16; const int2 inf = ri[pos];
                const float rs = __int_as_float(inf.y), w = wt[pos];
                const f32x4 g0 = acc[ai][0][m][0] * rs, g1 = acc[ai][0][m][1] * rs, u0 = acc[ai][1][m][0] * (rs * w), u1 = acc[ai][1][m][1] * (rs * w);
                u32x4 o; o.x = cvt_pk_bf16(siluf(g0[0]) * u0[0], siluf(g0[1]) * u0[1]); o.y = cvt_pk_bf16(siluf(g0[2]) * u0[2], siluf(g0[3]) * u0[3]);
                o.z = cvt_pk_bf16(siluf(g1[0]) * u1[0], siluf(g1[1]) * u1[1]); o.w = cvt_pk_bf16(siluf(g1[2]) * u1[2], siluf(g1[3]) * u1[3]);
                *(u32x4*)(act + (size_t)pos * ED + un.pn * 128 + wc * 32 + 8 * fq) = o; }
        return false;
    }
};
struct DownSched {
    int G, c, r; const LAS int* lo; const LAS int* tst; const LAS unsigned char* t2e; const char* Ar; const char* As_; const char* Br; const char* Bs_;
    __device__ __forceinline__ bool next(int i, pg8::Unit& u) const { const LAS int* ts = tst + r * 65; const int ntl = ts[64];
        if (!pg8::static_tile(i, G, c, ntl + TR / 256, 4, u.pm, u.pn)) return false;
        if (u.pm < ntl) { const int e = t2e[r * T2S + u.pm]; const int row0 = lo[r * 64 + e] + 256 * (u.pm - ts[e]);
            u.A = Ar + (size_t)row0 * ED * 2; u.B = Br + (size_t)e * D * ED * 2 + (size_t)u.pn * 256 * ED * 2; u.tag = 0; u.r0 = row0; u.rend = lo[(r + 1) * 64 + e]; }
        else { const int t0 = r * TR + 256 * (u.pm - ntl); u.A = As_ + (size_t)t0 * SD * 2; u.B = Bs_ + (size_t)u.pn * 256 * SD * 2; u.tag = 1; u.r0 = t0; u.rend = t0 + 256; }
        return true; }
    __device__ __forceinline__ int row(const pg8::Unit&, int r_) const { return r_; }
};
__device__ __forceinline__ unsigned pack_fp8x4(f32x4 v) {
    const float a0 = __builtin_amdgcn_fmed3f(v[0], -448.f, 448.f), a1 = __builtin_amdgcn_fmed3f(v[1], -448.f, 448.f), a2 = __builtin_amdgcn_fmed3f(v[2], -448.f, 448.f), a3 = __builtin_amdgcn_fmed3f(v[3], -448.f, 448.f);
    int w = __builtin_amdgcn_cvt_pk_fp8_f32(a0, a1, 0, false); w = __builtin_amdgcn_cvt_pk_fp8_f32(a2, a3, w, true); return (unsigned)w; }
struct EpiDown {
    static constexpr bool PERM = true;
    unsigned char* Y; const int2* ri; int ybase;
    __device__ __forceinline__ bool operator()(f32x4 (&acc)[2][2][4][2], const pg8::Unit& un, int wr, int wc, int fr, int fq) const {
        const int row0 = un.r0 + wr * 64 + fr;
#pragma unroll
        for (int ai = 0; ai < 2; ++ai)
#pragma unroll
            for (int m = 0; m < 4; ++m) { const int pos = row0 + ai * 128 + m * 16; int yrow; const bool ok = pos < un.rend;
                if (un.tag == 0) yrow = (ok ? ri[pos].x : ybase) - ybase; else yrow = pos * 9 + 8 - ybase;
                if (ok) { unsigned char* yr = Y + (size_t)yrow * 1024 + un.pn * 256 + wc * 64 + 16 * fq;
                    u32x4 o; o.x = pack_fp8x4(acc[ai][0][m][0]); o.y = pack_fp8x4(acc[ai][0][m][1]); o.z = pack_fp8x4(acc[ai][1][m][0]); o.w = pack_fp8x4(acc[ai][1][m][1]); *(u32x4*)yr = o; } }
        return false;
    }
};

#define XB_TMO      128
#define XB_XCNT(j)  (256  + 64 * (j))
#define XB_XSUB(j)  (1280 + 64 * (j))
#define XB_XGEN(j)  (2304 + 64 * (j))
#define XB_TOP      3328
#define XB_TOPGEN   3392
#define XCD_BAR_WORDS 3456
#define XB_SPIN_CAP (1u << 22)
__device__ __forceinline__ unsigned xb_ld(unsigned* p)              { return __hip_atomic_load(p, __ATOMIC_RELAXED, __HIP_MEMORY_SCOPE_AGENT); }
__device__ __forceinline__ unsigned xb_add(unsigned* p, unsigned v) { return __hip_atomic_fetch_add(p, v, __ATOMIC_RELAXED, __HIP_MEMORY_SCOPE_AGENT); }
__device__ __forceinline__ unsigned xb_xcc_id() { return (unsigned)__builtin_amdgcn_s_getreg((3 << 11) | 20) & 0xFu; }
#define XB_SPIN(cond, bar) do { unsigned _sp = 0; while (cond) { __builtin_amdgcn_s_sleep(1); \
    if ((++_sp & 255u) == 0u) { if (xb_ld(&(bar)[XB_TMO])) break; if (_sp > XB_SPIN_CAP) { atomicAdd(&(bar)[XB_TMO], 1u); break; } } } } while (0)
struct XcdBarrier { unsigned* bar; unsigned x; volatile LAS unsigned* st; };
__device__ __forceinline__ XcdBarrier xcd_barrier_post(unsigned* bar, volatile LAS unsigned* st, bool first_wave) {
    XcdBarrier b; b.bar = bar; b.x = xb_xcc_id(); b.st = st;
    if (lane_id() == 0 && first_wave) (void)xb_add(&bar[XB_XCNT(b.x)], 1u);
    return b;
}
__device__ __forceinline__ void xcd_barrier_complete(unsigned* bar, unsigned x, unsigned& nloc, unsigned& nx) {
    const unsigned G = gridDim.x * gridDim.y * gridDim.z;
    unsigned sum, cnt, mine, sp = 0u;
    for (;;) {
        sum = 0u; cnt = 0u; mine = 0u;
#pragma unroll
        for (unsigned j = 0; j < 16; ++j) { const unsigned c = xb_ld(&bar[XB_XCNT(j)]); sum += c; cnt += (c > 0u) ? 1u : 0u; mine = (j == x) ? c : mine; }
        if (sum == G) break;
        __builtin_amdgcn_s_sleep(1);
        if ((++sp & 255u) == 0u) { if (xb_ld(&bar[XB_TMO])) break; if (sp > XB_SPIN_CAP) { atomicAdd(&bar[XB_TMO], 1u); break; } }
    }
    nloc = mine > 0u ? mine : 1u; nx = cnt > 0u ? cnt : 1u;
}
__device__ __forceinline__ void xcd_barrier(const XcdBarrier& b, int tid) {
    asm volatile("s_waitcnt vmcnt(0)" ::: "memory");
    __syncthreads();
    if (tid == 0) {
        unsigned* bar = b.bar; unsigned bx = b.x; asm volatile("" : "+s"(bx));
        __builtin_amdgcn_s_waitcnt(0);
        unsigned nloc = b.st[0], nx = b.st[1];
        if (nloc == 0u) { xcd_barrier_complete(bar, bx, nloc, nx); b.st[0] = nloc; b.st[1] = nx; }
        const unsigned old = xb_add(&bar[XB_XSUB(bx)], 1u);
        const unsigned gen = old / nloc;
        if (old + 1u == (gen + 1u) * nloc) {
            __builtin_amdgcn_fence(__ATOMIC_RELEASE, "agent");
            asm volatile("s_waitcnt vmcnt(0)" ::: "memory");
            const unsigned og = xb_add(&bar[XB_TOP], 1u);
            const unsigned tg = og / nx;
            if (og + 1u == (tg + 1u) * nx) xb_add(&bar[XB_TOPGEN], 1u);
            else XB_SPIN(xb_ld(&bar[XB_TOPGEN]) == tg, bar);
            __builtin_amdgcn_fence(__ATOMIC_ACQUIRE, "agent");
            xb_add(&bar[XB_XGEN(bx)], 1u);
            asm volatile("s_waitcnt vmcnt(0)" ::: "memory");
        } else {
            XB_SPIN(xb_ld(&bar[XB_XGEN(bx)]) == gen, bar);
            __builtin_amdgcn_fence(__ATOMIC_ACQUIRE, "agent");
            asm volatile("s_waitcnt vmcnt(0)" ::: "memory");
        }
    }
    __syncthreads();
}

typedef float f32x16 __attribute__((ext_vector_type(16)));
typedef short s16x4 __attribute__((ext_vector_type(4)));
__device__ __forceinline__ void attn_phase(LAS unsigned char* lds, const bf16_t* __restrict__ u, bf16_t* __restrict__ attn, const float* __restrict__ sinks, const float* __restrict__ qg, const float* __restrict__ kg, int G, int wv_) {
    int tid_ = wv_ * 64 + lane_id(); asm volatile("" : "+v"(tid_));
    const int tid = tid_, lane = tid & 63, wave = __builtin_amdgcn_readfirstlane(tid >> 6), r32 = lane & 31, hi = lane >> 5;
    u32x4 kreg[4], vreg[4];
#define ATT_LOAD(un_) do { const int kvh_ = (un_) & 1, t0_ = ((un_) >> 1) * 128; _Pragma("unroll") for (int it = 0; it < 4; ++it) { const int i = tid + it * NT, j = i >> 3, ch = i & 7; int tok = t0_ - 128 + j; tok = tok < 0 ? 0 : tok; \
        kreg[it] = *(const u32x4*)(u + (size_t)tok * IND + POOLD + QD + kvh_ * 64 + ch * 8); vreg[it] = *(const u32x4*)(u + (size_t)tok * IND + POOLD + QD + KVD + kvh_ * 64 + ch * 8); } } while (0)
    if ((int)blockIdx.x < (T / 128) * 2) ATT_LOAD((int)blockIdx.x);
    for (int un = blockIdx.x; un < (T / 128) * 2; un += G) {
        const int kvh = un & 1, blk = un >> 1, t0 = blk * 128; const bool first = (t0 % SEQ) == 0;
#pragma unroll
        for (int it = 0; it < 4; ++it) { const int i = tid + it * NT, j = i >> 3, ch = i & 7;
            u32x4 kk = kreg[it]; const u32x4 vv = vreg[it];
            {
                float f[8] = {bf2f(kk.x & 0xffffu), bf2f(kk.x >> 16), bf2f(kk.y & 0xffffu), bf2f(kk.y >> 16), bf2f(kk.z & 0xffffu), bf2f(kk.z >> 16), bf2f(kk.w & 0xffffu), bf2f(kk.w >> 16)};
                float ss = 0.f;
#pragma unroll
                for (int q = 0; q < 8; ++q) ss += f[q] * f[q];
                ss += __shfl_xor(ss, 1); ss += __shfl_xor(ss, 2); ss += __shfl_xor(ss, 4);
                const float r = rsqrtf(ss * (1.f / 64.f) + EPS); const float* gp = kg + 8 * ch;
                kk.x = pk2(f[0] * r * gp[0], f[1] * r * gp[1]); kk.y = pk2(f[2] * r * gp[2], f[3] * r * gp[3]); kk.z = pk2(f[4] * r * gp[4], f[5] * r * gp[5]); kk.w = pk2(f[6] * r * gp[6], f[7] * r * gp[7]); }
            *(LAS u32x4*)(lds + j * 128 + ((ch ^ (j & 7)) * 16)) = kk;
            *(LAS u32x4*)(lds + 32768 + j * 128 + ch * 16) = vv; }
        if (un + G < (T / 128) * 2) ATT_LOAD(un + G);
        __syncthreads();
#pragma unroll 1
        for (int task = wave; task < 16; task += 8) {
            const int hq = task & 3, rb = task >> 2, h = kvh * 4 + hq; const int tq = t0 + 32 * rb + r32;
            const float slope2 = exp2f(-(float)(h + 1)) * LOG2E, sink2 = sinks[h] * LOG2E;
            bf16x8 qf[4];
            {
                u32x4 qr[4]; float ss = 0.f;
#pragma unroll
                for (int ds = 0; ds < 4; ++ds) { qr[ds] = *(const u32x4*)(u + (size_t)tq * IND + POOLD + h * 64 + 16 * ds + 8 * hi);
                    const float f[8] = {bf2f(qr[ds].x & 0xffffu), bf2f(qr[ds].x >> 16), bf2f(qr[ds].y & 0xffffu), bf2f(qr[ds].y >> 16), bf2f(qr[ds].z & 0xffffu), bf2f(qr[ds].z >> 16), bf2f(qr[ds].w & 0xffffu), bf2f(qr[ds].w >> 16)};
#pragma unroll
                    for (int q = 0; q < 8; ++q) ss += f[q] * f[q]; }
                ss += __shfl_xor(ss, 32);
                const float r = rsqrtf(ss * (1.f / 64.f) + EPS) * (0.125f * LOG2E);
#pragma unroll
                for (int ds = 0; ds < 4; ++ds) { const float* gp = qg + 16 * ds + 8 * hi;
                    const float f[8] = {bf2f(qr[ds].x & 0xffffu), bf2f(qr[ds].x >> 16), bf2f(qr[ds].y & 0xffffu), bf2f(qr[ds].y >> 16), bf2f(qr[ds].z & 0xffffu), bf2f(qr[ds].z >> 16), bf2f(qr[ds].w & 0xffffu), bf2f(qr[ds].w >> 16)};
                    u32x4 w; w.x = pk2(f[0] * r * gp[0], f[1] * r * gp[1]); w.y = pk2(f[2] * r * gp[2], f[3] * r * gp[3]); w.z = pk2(f[4] * r * gp[4], f[5] * r * gp[5]); w.w = pk2(f[6] * r * gp[6], f[7] * r * gp[7]);
                    qf[ds] = __builtin_bit_cast(bf16x8, w); } }
            f32x16 sc[5];
            const LAS unsigned char* kbase = lds + (32 * rb + r32) * 128;
            int kch[4];
#pragma unroll
            for (int ds = 0; ds < 4; ++ds) kch[ds] = ((2 * ds + hi) ^ (r32 & 7)) * 16;
#pragma unroll
            for (int tt = 0; tt < 5; ++tt) {
#pragma unroll
                for (int r = 0; r < 16; ++r) sc[tt][r] = 0.f;
#pragma unroll
                for (int ds = 0; ds < 4; ++ds) { const bf16x8 kf = *(const LAS bf16x8*)(kbase + kch[ds] + tt * 4096);
                    sc[tt] = __builtin_amdgcn_mfma_f32_32x32x16_bf16(kf, qf[ds], sc[tt], 0, 0, 0); } }
            float mx = -INFINITY;
            int lq = r32 - 4 * hi, lf = 32 * rb + 4 * hi; asm volatile("" : "+v"(lq), "+v"(lf));
            const float lbase = slope2 * (float)(128 + lq);
#pragma unroll
            for (int tt = 0; tt < 5; ++tt)
#pragma unroll
                for (int r = 0; r < 16; ++r) { const int c0 = (r & 3) + 8 * (r >> 2), cc = 32 * tt + c0;
                    float v = fmaf(slope2, (float)cc, sc[tt][r] - lbase);
                    bool ok = true; if (tt == 0) ok = c0 > lq; if (tt == 4) ok = c0 <= lq;
                    if (first && (lf < 128 - cc)) ok = false;
                    v = ok ? v : -INFINITY; sc[tt][r] = v; mx = fmaxf(mx, v); }
            mx = fmaxf(mx, __shfl_xor(mx, 32)); mx = fmaxf(mx, sink2);
            float ls = 0.f;
#pragma unroll
            for (int tt = 0; tt < 5; ++tt)
#pragma unroll
                for (int r = 0; r < 16; ++r) { const float p = __builtin_amdgcn_exp2f(sc[tt][r] - mx); sc[tt][r] = p; ls += p; }
            ls += __shfl_xor(ls, 32); ls += __builtin_amdgcn_exp2f(sink2 - mx);
            const float inv = 1.f / ls;
            f32x16 o[2];
#pragma unroll
            for (int db = 0; db < 2; ++db)
#pragma unroll
                for (int r = 0; r < 16; ++r) o[db][r] = 0.f;
            const int g4 = lane >> 4, i16 = lane & 15;
            const LAS unsigned char* vbase = lds + 32768 + (32 * rb + 4 * (g4 >> 1) + (i16 >> 2)) * 128 + (16 * (g4 & 1) + 4 * (i16 & 3)) * 2;
#pragma unroll
            for (int tt = 0; tt < 5; ++tt)
#pragma unroll
                for (int s2 = 0; s2 < 2; ++s2) {
                    u32x4 pw; pw.x = cvt_pk_bf16(sc[tt][8 * s2 + 0], sc[tt][8 * s2 + 1]); pw.y = cvt_pk_bf16(sc[tt][8 * s2 + 2], sc[tt][8 * s2 + 3]);
                    pw.z = cvt_pk_bf16(sc[tt][8 * s2 + 4], sc[tt][8 * s2 + 5]); pw.w = cvt_pk_bf16(sc[tt][8 * s2 + 6], sc[tt][8 * s2 + 7]);
                    const bf16x8 pb = __builtin_bit_cast(bf16x8, pw);
#pragma unroll
                    for (int db = 0; db < 2; ++db) {
                        const s16x4 lo = __builtin_bit_cast(s16x4, __builtin_amdgcn_ds_read_tr16_b64_v4i16((LAS s16x4*)(vbase + tt * 4096 + s2 * 2048 + db * 64)));
                        const s16x4 hi4 = __builtin_bit_cast(s16x4, __builtin_amdgcn_ds_read_tr16_b64_v4i16((LAS s16x4*)(vbase + tt * 4096 + s2 * 2048 + 1024 + db * 64)));
                        const bf16x8 vf = (bf16x8){lo[0], lo[1], lo[2], lo[3], hi4[0], hi4[1], hi4[2], hi4[3]};
                        o[db] = __builtin_amdgcn_mfma_f32_32x32x16_bf16(vf, pb, o[db], 0, 0, 0); } }
            bf16_t* orow = attn + (size_t)tq * QD + h * 64 + 4 * hi;
#pragma unroll
            for (int db = 0; db < 2; ++db)
#pragma unroll
                for (int gq = 0; gq < 4; ++gq) { u32x2 w; w.x = cvt_pk_bf16(o[db][4 * gq + 0] * inv, o[db][4 * gq + 1] * inv); w.y = cvt_pk_bf16(o[db][4 * gq + 2] * inv, o[db][4 * gq + 3] * inv);
                    *(u32x2*)(orow + 32 * db + 8 * gq) = w; }
        }
        __syncthreads();
    }
#undef ATT_LOAD
}

__global__ void __launch_bounds__(NT, 2) mk_fwd(P a) {
    cg::grid_group grid = cg::this_grid();
    extern __shared__ __attribute__((aligned(16))) unsigned char lds[];
    LAS unsigned char* lds3 = (LAS unsigned char*)lds;
    const int wave_s = __builtin_amdgcn_readfirstlane((int)threadIdx.x >> 6);
    int tid, half, vt, tx, ty, lane, wave; float (*As)[68]; float (*Bs)[64]; size_t gtid;
#define REFRESH() do { tid = wave_s * 64 + lane_id(); asm volatile("" : "+v"(tid)); half = tid >> 8; vt = tid & 255; tx = vt & 15; ty = vt >> 4; lane = tid & 63; wave = tid >> 6; \
        As = (float (*)[68])(lds + half * 8704); Bs = (float (*)[64])(lds + half * 8704 + 4352); gtid = (size_t)blockIdx.x * NT + tid; } while (0)
    REFRESH();
    if (tid < 2) ((volatile LAS unsigned*)(lds3 + LDS_TAB + 1024))[tid] = 0u;
    __syncthreads();
    const XcdBarrier xbar = xcd_barrier_post((unsigned*)(a.ws + C_BAR), (volatile LAS unsigned*)(lds3 + LDS_TAB + 1024), wave_s == 0);
    const int G = gridDim.x; const size_t gthreads = (size_t)G * NT; const int nwaves = G * (NT / 64);
#define Wcat ((bf16_t*)(a.ws + W_CAT))
#define Wpp ((bf16_t*)(a.ws + W_PP))
#define Wmix ((bf16_t*)(a.ws + W_MIX))
#define Wa_ ((bf16_t*)(a.ws + W_A))
#define Wb_ ((bf16_t*)(a.ws + W_B))
#define Wout ((bf16_t*)(a.ws + W_OUT))
#define Wsh ((bf16_t*)(a.ws + W_SH))
#define Wr ((bf16_t*)(a.ws + W_R))
#define Wsd ((bf16_t*)(a.ws + W_SD))
#define Wpg ((bf16_t*)(a.ws + W_PG))
#define Wexp ((bf16_t*)(a.ws + W_EXP))
#define Wed ((bf16_t*)(a.ws + W_ED))
#define rsspp ((float*)(a.ws + C_RSPP))
#define rss2 ((float*)(a.ws + C_RS2))
#define rss3 ((float*)(a.ws + C_RS3))
#define cntblk ((int*)(a.ws + C_CNTBLK))
#define sel ((int*)(a.ws + C_SEL))
#define tokl ((int*)(a.ws + C_TOKL))
#define rinfo ((int2*)(a.ws + C_RINFO))
#define wl ((float*)(a.ws + LOGITS))
#define Yb ((unsigned char*)(a.ws + YB))
#define wts ((float*)(a.ws + C_WTS))
#define ppb ((bf16_t*)(a.ws + PP))
#define hb ((bf16_t*)(a.ws + HB))
#define pb ((bf16_t*)(a.ws + PB))
#define ub ((bf16_t*)(a.ws + UB))
#define gb ((bf16_t*)(a.ws + GB))
#define poolb ((bf16_t*)(a.ws + POOLB))
#define logits ((float*)(a.ws + LOGITS))
#define attnb ((bf16_t*)(a.ws + HB))
#define mixb ((bf16_t*)(a.ws + HB + 32 * MiB))
#define mergedb ((bf16_t*)(a.ws + UB))
#define hg2 ((bf16_t*)(out))
#define hg3 ((bf16_t*)(a.ws + W_EXP))
#define actsh ((bf16_t*)(a.ws + ACTSH))
#define actr ((bf16_t*)(a.ws + ACTR))
#define out (a.out)
    {
        LAS float* scr = (LAS float*)(lds3 + wave * 16384);
        const int gw = blockIdx.x * (NT / 64) + wave;
        constexpr int I_IN = 16 * 40, I_G = 16 * 64, I_PP = 4 * 32, I_AB = 8 * 32, I_SQ = 16 * 32, I_GU = 16 * 8, I_R = 16 * 2, I_SD = 4 * 32;
        constexpr int I_E = NE * 128;
        constexpr int NITEMS = I_IN + I_G + I_PP + 2 * I_AB + 2 * I_SQ + 2 * I_GU + I_R + I_SD + 3 * I_E;
        auto decode = [&](int it) -> TItem { int r = it;
            if (r < I_IN) return ti_plain(a.w_in, D, IND, Wcat, 0, r); r -= I_IN;
            if (r < I_G) return ti_gate(a.w_gate, Wcat, r); r -= I_G;
            if (r < I_PP) return ti_plain(a.w_pp, PLE, D, Wpp, 0, r); r -= I_PP;
            if (r < I_AB) return ti_plain(a.w_a, 512, D, Wa_, 0, r); r -= I_AB;
            if (r < I_AB) return ti_plain(a.w_b, 512, D, Wb_, 0, r); r -= I_AB;
            if (r < I_SQ) return ti_plain(a.w_out, D, D, Wout, 0, r); r -= I_SQ;
            if (r < I_SQ) return ti_plain(a.w_pg, D, D, Wpg, 0, r, a.g_ple); r -= I_SQ;
            if (r < I_GU) return ti_gu(a.w_sg, Wsh, 0, r, a.g_ffn); r -= I_GU;
            if (r < I_GU) return ti_gu(a.w_su, Wsh, 1, r, a.g_ffn); r -= I_GU;
            if (r < I_R) return ti_plain(a.w_router, D, NE, Wr, 0, r, a.g_ffn); r -= I_R;
            if (r < I_SD) return ti_plain(a.w_sd, SD, D, Wsd, 0, r); r -= I_SD;
            if (r < I_E) { const int e = r >> 7; return ti_gu(a.w_eg + (size_t)e * D * ED, Wexp + (size_t)e * 512 * D, 0, r & 127, a.g_ffn); } r -= I_E;
            if (r < I_E) { const int e = r >> 7; return ti_gu(a.w_eu + (size_t)e * D * ED, Wexp + (size_t)e * 512 * D, 1, r & 127, a.g_ffn); } r -= I_E;
            { const int e = r >> 7; return ti_plain(a.w_ed + (size_t)e * ED * D, ED, D, Wed + (size_t)e * D * ED, 0, r & 127); } };
        if (gw < NITEMS) {
            TItem cur_ = decode(gw); f32x4 va[8], vb[8]; ti_load(cur_, va, lane);
            for (int it = gw; it < NITEMS; it += 2 * nwaves) {
                const int i1 = it + nwaves, i2 = it + 2 * nwaves; TItem n1 = cur_, n2 = cur_;
                if (i1 < NITEMS) { n1 = decode(i1); ti_load(n1, vb, lane); }
                ti_finish(cur_, va, scr, lane);
                if (i1 < NITEMS) { if (i2 < NITEMS) { n2 = decode(i2); ti_load(n2, va, lane); } ti_finish(n1, vb, scr, lane); cur_ = n2; }
            }
        }
        for (size_t i = gtid; i < (size_t)2 * 256 * 256; i += gthreads) { const int pn = (int)(i >> 16), n = (int)((i >> 8) & 255), k = (int)(i & 255);
            const float v = ((n >> 7) == (k >> 7)) ? a.w_pool_mix[(size_t)(2 * pn + (n >> 7)) * 128 * 128 + (size_t)(k & 127) * 128 + (n & 127)] * a.pool_scale[256 * pn + n] : 0.f;
            Wmix[i] = (bf16_t)f2bf(v); }
        for (size_t i = gtid; i < (size_t)192 * D / 8; i += gthreads) *((u32x4*)(Wr + (size_t)64 * D) + i) = (u32x4){0u, 0u, 0u, 0u};
        for (int m0 = gw; m0 < T; m0 += 2 * nwaves) {
            f32x4 v[2][4], pv[2]; float sq[2];
#pragma unroll
            for (int rr = 0; rr < 2; ++rr) { const int m = (m0 + rr * nwaves < T) ? m0 + rr * nwaves : m0; const f32x4* xr = (const f32x4*)(a.x + (size_t)m * D) + lane;
#pragma unroll
                for (int j = 0; j < 4; ++j) v[rr][j] = xr[64 * j];
                pv[rr] = *((const f32x4*)(a.p + (size_t)m * PLE) + lane); }
#pragma unroll
            for (int rr = 0; rr < 2; ++rr) { float s_ = 0.f;
#pragma unroll
                for (int j = 0; j < 4; ++j) s_ += (v[rr][j].x * v[rr][j].x + v[rr][j].y * v[rr][j].y) + (v[rr][j].z * v[rr][j].z + v[rr][j].w * v[rr][j].w);
                sq[rr] = wave_sum(s_); }
#pragma unroll
            for (int rr = 0; rr < 2; ++rr) { const int m = m0 + rr * nwaves; if (m < T) { const float r = rsqrtf(sq[rr] * (1.f / D) + EPS);
                u32x2* o8 = (u32x2*)(hb + (size_t)m * D) + lane;
#pragma unroll
                for (int j = 0; j < 4; ++j) { const f32x4 gg = *((const f32x4*)a.g_mix + lane + 64 * j); u32x2 w; w.x = pk2(v[rr][j].x * r * gg.x, v[rr][j].y * r * gg.y); w.y = pk2(v[rr][j].z * r * gg.z, v[rr][j].w * r * gg.w); o8[64 * j] = w; }
                u32x2 w; w.x = pk2(pv[rr].x, pv[rr].y); w.y = pk2(pv[rr].z, pv[rr].w); *((u32x2*)(pb + (size_t)m * PLE) + lane) = w; } }
        }
        for (size_t i = gtid; i < (size_t)T; i += gthreads) { rsspp[i] = 0.f; rss2[i] = 0.f; rss3[i] = 0.f; }
    }
    if (gridDim.x == 0x7fffffffu) grid.sync();
    xcd_barrier(xbar, tid); REFRESH();
    {
        pg8::Cfg g1{(unsigned)D * 2u, (unsigned)D * 2u, D};
        pg8::DenseSched S1{T / 256, NCAT / 256, G, (int)blockIdx.x, (const char*)hb, (const char*)Wcat, (size_t)256 * D * 2, (size_t)256 * D * 2};
        EpiG1 E1{ub, gb, a.b_gate};
        pg8::gemm_phase<EpiG1, pg8::DenseSched, false>(lds3, g1, S1, E1, wave_s);
        pg8::Cfg g2{(unsigned)PLE * 2u, (unsigned)PLE * 2u, PLE};
        PPSched S2{G, (int)blockIdx.x, (const char*)pb, (const char*)Wpp};
        EpiPP E2{ppb, rsspp};
        pg8::gemm_phase<EpiPP, PPSched, false>(lds3, g2, S2, E2, wave_s);
    }
    xcd_barrier(xbar, tid); REFRESH();
    for (int i = 0;; ++i) { int pm, pn; if (!pg8::static_tile(i, G, (int)blockIdx.x, T / 256, 2, pm, pn)) break;
        const int ch = tid & 31, rg = tid >> 5, col = 256 * pn + 8 * ch, w = 2 << (col >> 7), t0 = 256 * pm + 16 * rg, pos0 = t0 % SEQ;
        const bf16_t* rp0 = ub + (size_t)t0 * IND + col; float sw[8];
#pragma unroll
        for (int q = 0; q < 8; ++q) sw[q] = 0.f;
        { u32x4 pv[15];
#pragma unroll
          for (int k = 1; k < 16; ++k) pv[k - 1] = *(const u32x4*)(rp0 - (size_t)((k < w && k <= pos0) ? k : 0) * IND);
#pragma unroll
          for (int k = 1; k < 16; ++k) { const float mk = (k < w && k <= pos0) ? 1.f : 0.f; const u32x4 p4 = pv[k - 1];
              sw[0] += mk * bf2f(p4.x & 0xffffu); sw[1] += mk * bf2f(p4.x >> 16); sw[2] += mk * bf2f(p4.y & 0xffffu); sw[3] += mk * bf2f(p4.y >> 16);
              sw[4] += mk * bf2f(p4.z & 0xffffu); sw[5] += mk * bf2f(p4.z >> 16); sw[6] += mk * bf2f(p4.w & 0xffffu); sw[7] += mk * bf2f(p4.w >> 16); } }
#pragma unroll 1
        for (int b4 = 0; b4 < 4; ++b4) { u32x4 nw[4], od[4];
#pragma unroll
            for (int j = 0; j < 4; ++j) { const int r = 4 * b4 + j; nw[j] = *(const u32x4*)(rp0 + (size_t)r * IND);
                od[j] = *(const u32x4*)(rp0 + (size_t)((pos0 + r >= w - 1) ? r - (w - 1) : r) * IND); }
#pragma unroll
            for (int j = 0; j < 4; ++j) { const int r = 4 * b4 + j; const int cn = pos0 + r + 1 < w ? pos0 + r + 1 : w; const float ic = 1.f / (float)cn, mo = (pos0 + r >= w - 1) ? 1.f : 0.f;
                const float c8[8] = {bf2f(nw[j].x & 0xffffu), bf2f(nw[j].x >> 16), bf2f(nw[j].y & 0xffffu), bf2f(nw[j].y >> 16), bf2f(nw[j].z & 0xffffu), bf2f(nw[j].z >> 16), bf2f(nw[j].w & 0xffffu), bf2f(nw[j].w >> 16)};
                const float o8[8] = {bf2f(od[j].x & 0xffffu), bf2f(od[j].x >> 16), bf2f(od[j].y & 0xffffu), bf2f(od[j].y >> 16), bf2f(od[j].z & 0xffffu), bf2f(od[j].z >> 16), bf2f(od[j].w & 0xffffu), bf2f(od[j].w >> 16)};
                float e8[8];
#pragma unroll
                for (int q = 0; q < 8; ++q) { sw[q] += c8[q]; e8[q] = sw[q] * ic - c8[q]; sw[q] -= mo * o8[q]; }
                u32x4 o; o.x = pk2(e8[0], e8[1]); o.y = pk2(e8[2], e8[3]); o.z = pk2(e8[4], e8[5]); o.w = pk2(e8[6], e8[7]);
                *(u32x4*)(poolb + (size_t)(t0 + r) * POOLD + col) = o; } } }
    asm volatile("s_waitcnt vmcnt(0)" ::: "memory");
    __syncthreads();
    {
        pg8::Cfg gm{(unsigned)POOLD * 2u, 512u, 256};
        MixSched Sm{G, (int)blockIdx.x, (const char*)poolb, (const char*)Wmix};
        EpiBf16Plain Em{mixb, POOLD};
        pg8::gemm_phase<EpiBf16Plain, MixSched, false>(lds3, gm, Sm, Em, wave_s);
    }
    REFRESH();
    attn_phase(lds3, ub, attnb, a.sinks, a.q_gain, a.k_gain, G, wave_s);
    xcd_barrier(xbar, tid); REFRESH();
    {
        pg8::Cfg g4{1024u, 1024u, 512};
        MergedSched S4{G, (int)blockIdx.x, (const char*)mixb, (const char*)attnb, (const char*)Wa_, (const char*)Wb_};
        EpiMerged E4{gb, mergedb};
        pg8::gemm_phase<EpiMerged, MergedSched, false>(lds3, g4, S4, E4, wave_s);
    }
    xcd_barrier(xbar, tid); REFRESH();
    {
        pg8::Cfg g5{(unsigned)D * 2u, (unsigned)D * 2u, D};
        pg8::DenseSched S5{T / 256, D / 256, G, (int)blockIdx.x, (const char*)mergedb, (const char*)Wout, (size_t)256 * D * 2, (size_t)256 * D * 2};
        EpiResid E5{a.x, hg2, rss2};
        pg8::gemm_phase<EpiResid, pg8::DenseSched, false>(lds3, g5, S5, E5, wave_s);
    }
    xcd_barrier(xbar, tid); REFRESH();
    {
        pg8::Cfg g6{(unsigned)D * 2u, (unsigned)D * 2u, D};
        P6Sched S6{G, (int)blockIdx.x, (const char*)hg2, (const char*)Wsh};
        EpiShared E6{actsh, logits, rss2};
        pg8::gemm_phase<EpiShared, P6Sched, false>(lds3, g6, S6, E6, wave_s);
    }
    REFRESH();
    if (G != 256) { xcd_barrier(xbar, tid); REFRESH(); }
    __syncthreads();
    for (int cpair = blockIdx.x; cpair < NCHUNK / 2; cpair += G) {
        float (*C)[65] = (float (*)[65])(lds + (wave & 3) * 16640);
        int* cw = (int*)(lds + 4 * 16640);
        const int ch = cpair * 2 + ((wave >> 1) & 1);
        int idx[8], rk[8]; float sv[8]; const int t = ch * 128 + (wave & 1) * 64 + lane;
        if (wave < 4) {
            { const f32x4* lg4 = (const f32x4*)(logits + (size_t)(t - lane) * 64); const f32x4 b4 = *((const f32x4*)a.router_bias + (lane & 15)); f32x4 lv[16];
#pragma unroll
              for (int i = 0; i < 16; ++i) lv[i] = lg4[i * 64 + lane];
#pragma unroll
              for (int i = 0; i < 16; ++i) { float* cr = &C[4 * i + (lane >> 4)][4 * (lane & 15)];
#pragma unroll
                  for (int q = 0; q < 4; ++q) cr[q] = 1.f / (1.f + expf(-lv[i][q])) + b4[q]; } }
            float gs[8];
#pragma unroll
            for (int g = 0; g < 8; ++g) { float m1 = -INFINITY, m2 = -INFINITY;
#pragma unroll
                for (int j = 0; j < 8; ++j) { const float v = C[lane][g * 8 + j]; if (v > m1) { m2 = m1; m1 = v; } else if (v > m2) m2 = v; }
                gs[g] = m1 + m2; }
            unsigned gsel = 0u;
#pragma unroll
            for (int it = 0; it < 4; ++it) { float best = -INFINITY; int bi = 0;
#pragma unroll
                for (int g = 0; g < 8; ++g) { const bool fr_ = !((gsel >> g) & 1u); if (fr_ && gs[g] > best) { best = gs[g]; bi = g; } }
                gsel |= 1u << bi; }
            unsigned long long chosen = 0ull; float wsum = 0.f;
#pragma unroll
            for (int g = 0; g < 8; ++g) if (!((gsel >> g) & 1u)) {
#pragma unroll
                for (int j = 0; j < 8; ++j) C[lane][g * 8 + j] = -INFINITY; }
#pragma unroll
            for (int k = 0; k < 8; ++k) { float best = -INFINITY; int bi = 0;
#pragma unroll 8
                for (int e = 0; e < 64; ++e) { const float v = C[lane][e]; if (v > best) { best = v; bi = e; } }
                C[lane][bi] = -INFINITY; chosen |= 1ull << bi; idx[k] = bi; sv[k] = 1.f / (1.f + expf(-logits[(size_t)t * 64 + bi])); wsum += sv[k]; rk[k] = 0; }
#pragma unroll
            for (int k = 0; k < 8; ++k) sv[k] = sv[k] / (wsum + 1e-20f) * 2.5f;
#pragma unroll 1
            for (int e = 0; e < 64; ++e) { const bool chs = (chosen >> e) & 1ull; const unsigned long long mm = __ballot(chs); const int r = __popcll(mm & ((1ull << lane) - 1ull));
                if (lane == 0) cw[wave * 64 + e] = __popcll(mm);
#pragma unroll
                for (int k = 0; k < 8; ++k) if (idx[k] == e) rk[k] = r; }
        }
        __syncthreads();
        if (wave < 4) {
#pragma unroll
            for (int k = 0; k < 8; ++k) { const int r = rk[k] + ((wave & 1) ? cw[(wave - 1) * 64 + idx[k]] : 0); sel[(size_t)t * 8 + k] = idx[k] | (r << 8); wts[(size_t)t * 8 + k] = sv[k]; }
            if ((wave & 1) == 0) cntblk[ch * 64 + lane] = cw[wave * 64 + lane] + cw[(wave + 1) * 64 + lane];
        }
        __syncthreads();
    }
    xcd_barrier(xbar, tid); REFRESH();
    {
        int* tot = (int*)(lds + 0); int* pst = (int*)(lds + 512); int* base = (int*)(lds + 1024); LAS int* mts = (LAS int*)(lds3 + LDS_TAB);
        int* part = (int*)(lds + 2048);
        LAS int* lo_t = (LAS int*)(lds3 + LDS_TAB + LT_LO); LAS int* tst_t = (LAS int*)(lds3 + LDS_TAB + LT_TST);
        LAS unsigned char* t2e7 = lds3 + LDS_TAB + LT_T2E7; LAS unsigned char* t2e8 = lds3 + LDS_TAB + LT_T2E8;
        const int e_ = tid & 63, pt = tid >> 6; const int ch0 = blockIdx.x;
        { int sr[NROUND + 1];
#pragma unroll
          for (int r = 0; r <= NROUND; ++r) sr[r] = 0;
#pragma unroll 4
          for (int c2 = pt; c2 < NCHUNK; c2 += 8) { const int v = cntblk[c2 * 64 + e_]; sr[0] += v; sr[NROUND] += (c2 < ch0) ? v : 0;
#pragma unroll
              for (int r = 1; r < NROUND; ++r) sr[r] += (c2 < r * (NCHUNK / NROUND)) ? v : 0; }
#pragma unroll
          for (int r = 0; r <= NROUND; ++r) part[r * 512 + pt * 64 + e_] = sr[r]; }
        __syncthreads();
        if (tid < 64) {
#pragma unroll
            for (int r = 0; r <= NROUND; ++r) { int sm = 0;
#pragma unroll
                for (int q = 0; q < 8; ++q) sm += part[r * 512 + q * 64 + tid];
                if (r == 0) tot[tid] = sm; else if (r == NROUND) base[tid] = sm; else lo_t[r * 64 + tid] = sm; } }
        __syncthreads();
        if (tid == 0) { int p = 0, m = 0; for (int e = 0; e < 64; ++e) { pst[e] = p; mts[e] = m; const int pd = (tot[e] + 255) & ~255; p += pd; m += pd >> 8; } pst[64] = p; mts[64] = m; mts[65] = m; }
        __syncthreads();
        if (tid < 64) { const int p0 = pst[tid]; lo_t[tid] = p0;
#pragma unroll
            for (int r = 1; r < NROUND; ++r) lo_t[r * 64 + tid] += p0;
            lo_t[NROUND * 64 + tid] = p0 + tot[tid];
            for (int j = mts[tid]; j < mts[tid + 1]; ++j) t2e7[j] = (unsigned char)tid; }
        __syncthreads();
        if (tid < NROUND) { int m = 0; for (int e = 0; e < 64; ++e) { tst_t[tid * 65 + e] = m; const int nt_ = (lo_t[(tid + 1) * 64 + e] - lo_t[tid * 64 + e] + 255) >> 8;
                for (int j = 0; j < nt_; ++j) t2e8[tid * T2S + (m + j)] = (unsigned char)e; m += nt_; } tst_t[tid * 65 + 64] = m; }
        __syncthreads();
        if ((int)blockIdx.x < 64 && tid < 256) { const int e = blockIdx.x; const int j = tot[e] + tid; if (j < ((tot[e] + 255) & ~255)) { tokl[pst[e] + j] = -1; rinfo[pst[e] + j] = make_int2(-1, 0); wl[pst[e] + j] = 0.f; } }
        for (int ch = blockIdx.x; ch < NCHUNK; ch += G) {
            if (ch != ch0) {
                __syncthreads();
                if (tid < 64) { int sum = 0;
#pragma unroll 4
                    for (int c2 = 0; c2 < ch; ++c2) sum += cntblk[c2 * 64 + tid];
                    base[tid] = sum; }
                __syncthreads();
            }
            if (tid < 128) { const int t = ch * 128 + tid;
#pragma unroll
                for (int k = 0; k < 8; ++k) { const int sl = sel[(size_t)t * 8 + k]; const int pos = pst[sl & 255] + base[sl & 255] + (sl >> 8);
                    tokl[pos] = t * 8 + k; rinfo[pos] = make_int2(t * 9 + k, __float_as_int(rsqrtf(rss2[t] * (1.f / D) + EPS))); wl[pos] = wts[(size_t)t * 8 + k]; } }
        }
    }
    xcd_barrier(xbar, tid); REFRESH();
    const int ntr = ((LAS int*)(lds3 + LDS_TAB))[64];
    {
        pg8::Cfg g7{(unsigned)D * 2u, (unsigned)D * 2u, D};
        RoutedUpSched S7{G, (int)blockIdx.x, ntr, (const LAS unsigned char*)(lds3 + LDS_TAB + LT_T2E7), tokl, (const char*)hg2, (const char*)Wexp};
        EpiRoutedUp E7{actr, rinfo, wl};
        pg8::gemm_phase<EpiRoutedUp, RoutedUpSched, true>(lds3, g7, S7, E7, wave_s);
    }
    xcd_barrier(xbar, tid); REFRESH();
#pragma unroll 1
    for (int q = 0; q <= NROUND; ++q) {
#pragma unroll 1
        for (int part2 = 0; part2 < 2; ++part2) {
            const bool do_down = (part2 == (int)(blockIdx.x & 1));
            if (do_down) { if (q < NROUND) {
                pg8::Cfg g8{(unsigned)ED * 2u, (unsigned)ED * 2u, ED};
                DownSched S8{G, (int)blockIdx.x, q, (const LAS int*)(lds3 + LDS_TAB + LT_LO), (const LAS int*)(lds3 + LDS_TAB + LT_TST), (const LAS unsigned char*)(lds3 + LDS_TAB + LT_T2E8), (const char*)actr, (const char*)actsh, (const char*)Wed, (const char*)Wsd};
                EpiDown E8{Yb + (size_t)(q & 1) * TR * 9 * 1024, rinfo, q * TR * 9};
                pg8::gemm_phase<EpiDown, DownSched, false>(lds3, g8, S8, E8, wave_s);
                REFRESH(); }
            } else if (q > 0) { const int qc = q - 1; const unsigned char* Yc = Yb + (size_t)(qc & 1) * TR * 9 * 1024;
                int rem = 0; if (q < NROUND) rem = ((((const LAS int*)(lds3 + LDS_TAB + LT_TST))[q * 65 + 64] + TR / 256) * 4) % G;
                if (rem > G / 2) rem = 0;
                const int li = (int)blockIdx.x - rem, nlw = (G - rem) * (NT / 64);
                if (li >= 0)
                for (int tl0 = li * (NT / 64) + wave; tl0 < TR; tl0 += 2 * nlw) { const int nwaves_c = nlw; const int col = lane * 16;
                    u32x4 y[2][9], xa[2], xb_[2];
#pragma unroll
                    for (int u2 = 0; u2 < 2; ++u2) { const int tl_ = (tl0 + u2 * nwaves_c < TR) ? tl0 + u2 * nwaves_c : tl0; const int t = qc * TR + tl_;
                        const unsigned char* yr = Yc + (size_t)tl_ * 9 * 1024 + col; const bf16_t* xi = hg2 + (size_t)t * D + col;
#pragma unroll
                        for (int k = 0; k < 9; ++k) y[u2][k] = *(const u32x4*)(yr + k * 1024);
                        xa[u2] = *(const u32x4*)xi; xb_[u2] = *(const u32x4*)(xi + 8); }
#pragma unroll
                    for (int u2 = 0; u2 < 2; ++u2) { const int tl_ = tl0 + u2 * nwaves_c; if (tl_ < TR) { const int t = qc * TR + tl_;
                        f32x4 v[4];
                        v[0] = (f32x4){bf2f(xa[u2].x & 0xffffu), bf2f(xa[u2].x >> 16), bf2f(xa[u2].y & 0xffffu), bf2f(xa[u2].y >> 16)}; v[1] = (f32x4){bf2f(xa[u2].z & 0xffffu), bf2f(xa[u2].z >> 16), bf2f(xa[u2].w & 0xffffu), bf2f(xa[u2].w >> 16)};
                        v[2] = (f32x4){bf2f(xb_[u2].x & 0xffffu), bf2f(xb_[u2].x >> 16), bf2f(xb_[u2].y & 0xffffu), bf2f(xb_[u2].y >> 16)}; v[3] = (f32x4){bf2f(xb_[u2].z & 0xffffu), bf2f(xb_[u2].z >> 16), bf2f(xb_[u2].w & 0xffffu), bf2f(xb_[u2].w >> 16)};
#pragma unroll
                        for (int k = 0; k < 9; ++k)
#pragma unroll
                            for (int j = 0; j < 4; ++j) { const f32x2 lo2 = __builtin_amdgcn_cvt_pk_f32_fp8((int)y[u2][k][j], false), hi2 = __builtin_amdgcn_cvt_pk_f32_fp8((int)y[u2][k][j], true);
                                v[j][0] += lo2.x; v[j][1] += lo2.y; v[j][2] += hi2.x; v[j][3] += hi2.y; }
                        float ss = 0.f; u32x4 w0, w1;
#pragma unroll
                        for (int j = 0; j < 4; ++j) { const unsigned p0 = pk2(v[j][0], v[j][1]), p1 = pk2(v[j][2], v[j][3]);
                            if (j == 0) { w0.x = p0; w0.y = p1; } else if (j == 1) { w0.z = p0; w0.w = p1; } else if (j == 2) { w1.x = p0; w1.y = p1; } else { w1.z = p0; w1.w = p1; }
                            ss += (v[j][0] * v[j][0] + v[j][1] * v[j][1]) + (v[j][2] * v[j][2] + v[j][3] * v[j][3]); }
                        *(u32x4*)(hg3 + (size_t)t * D + col) = w0; *(u32x4*)(hg3 + (size_t)t * D + col + 8) = w1;
                        ss = wave_sum(ss);
                        if (lane == 0) rss3[t] = ss; } }
                }
            }
        }
        xcd_barrier(xbar, tid); REFRESH();
    }
    {
        pg8::Cfg g9{(unsigned)D * 2u, (unsigned)D * 2u, D};
        pg8::DenseSched S9{T / 256, D / 256, G, (int)blockIdx.x, (const char*)hg3, (const char*)Wpg, (size_t)256 * D * 2, (size_t)256 * D * 2};
        EpiFinal E9{out, hg3, ppb, rss3, rsspp, a.g_post};
        pg8::gemm_phase<EpiFinal, pg8::DenseSched, false>(lds3, g9, S9, E9, wave_s);
    }
}
#undef Wcat
#undef Wpp
#undef Wmix
#undef Wa_
#undef Wb_
#undef Wout
#undef Wsh
#undef Wr
#undef Wsd
#undef Wpg
#undef Wexp
#undef Wed
#undef rsspp
#undef rss2
#undef rss3
#undef cntblk
#undef sel
#undef tokl
#undef rinfo
#undef wl
#undef Yb
#undef wts
#undef ppb
#undef hb
#undef pb
#undef ub
#undef gb
#undef poolb
#undef logits
#undef attnb
#undef mixb
#undef mergedb
#undef hg2
#undef hg3
#undef actsh
#undef actr
#undef out
}

extern "C" void kernel_launch(void* const* d_in, const int* in_sizes, int n_in, void* d_out, int out_size, void* d_ws, size_t ws_size, hipStream_t stream) {
    using namespace mk;
    static int grid_blocks = 0;
    constexpr size_t LDSB = 147456;
    if (!grid_blocks) {
        int dev = 0, cus = 0, per_cu = 0;
        (void)hipGetDevice(&dev); (void)hipDeviceGetAttribute(&cus, hipDeviceAttributeMultiprocessorCount, dev);
        (void)hipFuncSetAttribute((const void*)mk_fwd, hipFuncAttributeMaxDynamicSharedMemorySize, (int)LDSB);
        (void)hipOccupancyMaxActiveBlocksPerMultiprocessor(&per_cu, (const void*)mk_fwd, NT, LDSB);
        if (per_cu < 1) { fprintf(stderr, "occupancy query says %d blocks per CU\n", per_cu); }
        grid_blocks = cus;
    }
    if (ws_size < (size_t)512 * MiB) { fprintf(stderr, "ws too small: %zu\n", ws_size); return; }
    P a{};
    a.x = (const float*)d_in[0]; a.p = (const float*)d_in[1]; a.g_mix = (const float*)d_in[2]; a.w_in = (const float*)d_in[3]; a.w_pool_mix = (const float*)d_in[4];
    a.pool_scale = (const float*)d_in[5]; a.w_a = (const float*)d_in[6]; a.q_gain = (const float*)d_in[7]; a.k_gain = (const float*)d_in[8]; a.sinks = (const float*)d_in[9];
    a.w_b = (const float*)d_in[10]; a.w_gate = (const float*)d_in[11]; a.b_gate = (const float*)d_in[12]; a.w_out = (const float*)d_in[13]; a.g_ffn = (const float*)d_in[14];
    a.w_router = (const float*)d_in[15]; a.router_bias = (const float*)d_in[16]; a.w_eg = (const float*)d_in[17]; a.w_eu = (const float*)d_in[18]; a.w_ed = (const float*)d_in[19];
    a.w_sg = (const float*)d_in[20]; a.w_su = (const float*)d_in[21]; a.w_sd = (const float*)d_in[22]; a.g_ple = (const float*)d_in[23]; a.w_pg = (const float*)d_in[24];
    a.w_pp = (const float*)d_in[25]; a.g_post = (const float*)d_in[26]; a.out = (float*)d_out; a.ws = (char*)d_ws;
    (void)hipMemsetAsync((char*)d_ws + C_BAR, 0, 16384, stream);
    void* args[] = {&a};
    hipError_t e = hipLaunchCooperativeKernel((const void*)mk_fwd, dim3(grid_blocks), dim3(NT), args, LDSB, stream);
    if (e != hipSuccess) fprintf(stderr, "cooperative launch failed: %s (grid %d)\n", hipGetErrorString(e), grid_blocks);
}
```

```cpp
#include <hip/hip_runtime.h>
#include <hip/hip_cooperative_groups.h>
#include <cstdio>
#include <cstdint>
namespace cg = cooperative_groups;

#define LAS __attribute__((address_space(3)))
typedef unsigned short bf16_t;
typedef short bf16x8 __attribute__((ext_vector_type(8)));
typedef float f32x4 __attribute__((ext_vector_type(4)));
typedef unsigned u32x4 __attribute__((ext_vector_type(4)));
typedef unsigned u32x2 __attribute__((ext_vector_type(2)));
typedef float f32x2 __attribute__((ext_vector_type(2)));

namespace mk {
constexpr int T = 32768, D = 1024, SEQ = 4096, PLE = 256;
constexpr int POOLD = 512, QD = 512, KVD = 128, IND = 1280, NCAT = 3328;
constexpr int NE = 64, ED = 256, SD = 256;
constexpr float EPS = 1e-6f;
constexpr float LOG2E = 1.4426950408889634f;
constexpr int NT = 512;
constexpr size_t MiB = 1u << 20;
constexpr size_t W_CAT = 0;
constexpr size_t W_PP = W_CAT + (size_t)NCAT * D * 2;
constexpr size_t W_MIX = W_PP + (size_t)D * PLE * 2;
constexpr size_t W_A = W_MIX + 2 * 256 * 256 * 2;
constexpr size_t W_B = W_A + (size_t)D * 512 * 2;
constexpr size_t W_OUT = W_B + (size_t)D * 512 * 2;
constexpr size_t W_SH = W_OUT + (size_t)D * D * 2;
constexpr size_t W_R = W_SH + (size_t)512 * D * 2;
constexpr size_t W_SD = W_R + (size_t)256 * D * 2;
constexpr size_t W_PG = W_SD + (size_t)D * 256 * 2;
constexpr size_t W_EXP = 16 * MiB;
constexpr size_t W_ED = 80 * MiB;
static_assert(W_PG + (size_t)D * D * 2 <= W_EXP, "weights map");
constexpr size_t CTL = 112 * MiB;
constexpr size_t C_RSPP = CTL, C_RS2 = CTL + 128 * 1024, C_RS3 = CTL + 256 * 1024;
constexpr size_t C_CNTBLK = CTL + 512 * 1024;
constexpr size_t C_SEL = CTL + 2 * MiB;
constexpr size_t C_TOKL = CTL + 3 * MiB;
constexpr size_t C_RINFO = CTL + 4 * MiB + 512 * 1024;
constexpr size_t YB = 184 * MiB;
constexpr size_t ACTSH = 464 * MiB;
constexpr int NCHUNK = T / 128;
constexpr size_t C_BAR = CTL + 7 * MiB + 512 * 1024;
constexpr int NROUND = 4, TR = T / NROUND;
constexpr int LT_LO = 4096, LT_TST = LT_LO + (NROUND + 1) * 64 * 4, LT_T2E7 = LT_TST + NROUND * 65 * 4, LT_T2E8 = LT_T2E7 + 1152;
constexpr int T2S = TR * 8 / 256 + 64;
constexpr int LT_CB = LT_T2E8 + NROUND * T2S;
static_assert(LT_CB % 4 == 0 && LT_CB + NROUND * 64 * 4 <= 16384 && TR / 128 * NROUND == T / 128, "LDS tables");
constexpr int LDS_TAB = 131072;
constexpr size_t C_WTS = CTL + 1 * MiB;
constexpr size_t PP = 120 * MiB;
constexpr size_t HB = 184 * MiB;
constexpr size_t PB = 248 * MiB;
constexpr size_t UB = 264 * MiB;
constexpr size_t GB = 344 * MiB;
constexpr size_t POOLB = 472 * MiB;
constexpr size_t LOGITS = 504 * MiB;
constexpr size_t ACTR = 328 * MiB;

__device__ __forceinline__ int lane_id() { int l; asm volatile("v_mbcnt_lo_u32_b32 %0, -1, 0\n\tv_mbcnt_hi_u32_b32 %0, -1, %0" : "=v"(l)); return l; }
__device__ __forceinline__ float bf2f(unsigned v) { return __uint_as_float(v << 16); }
__device__ __forceinline__ unsigned f2bf(float f) { unsigned u = __float_as_uint(f); return (u + 0x7fffu + ((u >> 16) & 1u)) >> 16; }
__device__ __forceinline__ unsigned cvt_pk_bf16(float lo, float hi) { unsigned r; asm volatile("v_cvt_pk_bf16_f32 %0, %1, %2" : "=v"(r) : "v"(lo), "v"(hi)); return r; }
__device__ __forceinline__ unsigned pk2(float lo, float hi) { return f2bf(lo) | (f2bf(hi) << 16); }
__device__ __forceinline__ float dpp_f(float v, int ctrl_sel) {
    const int i = __float_as_int(v); int r;
    if (ctrl_sel == 0) r = __builtin_amdgcn_update_dpp(i, i, 0xB1, 0xF, 0xF, false);
    else if (ctrl_sel == 1) r = __builtin_amdgcn_update_dpp(i, i, 0x4E, 0xF, 0xF, false);
    else if (ctrl_sel == 2) r = __builtin_amdgcn_update_dpp(i, i, 0x141, 0xF, 0xF, false);
    else r = __builtin_amdgcn_update_dpp(i, i, 0x140, 0xF, 0xF, false);
    return __int_as_float(r); }
__device__ __forceinline__ float xsum16(float s) { const unsigned u = __float_as_uint(s); auto r = __builtin_amdgcn_permlane16_swap(u, u, false, false); return __uint_as_float(r[0]) + __uint_as_float(r[1]); }
__device__ __forceinline__ float xsum32(float s) { const unsigned u = __float_as_uint(s); auto r = __builtin_amdgcn_permlane32_swap(u, u, false, false); return __uint_as_float(r[0]) + __uint_as_float(r[1]); }
__device__ __forceinline__ float xmax32(float s) { const unsigned u = __float_as_uint(s); auto r = __builtin_amdgcn_permlane32_swap(u, u, false, false); return fmaxf(__uint_as_float(r[0]), __uint_as_float(r[1])); }
__device__ __forceinline__ float sum8(float v) { v += dpp_f(v, 0); v += dpp_f(v, 1); v += dpp_f(v, 2); return v; }
__device__ __forceinline__ float wave_sum(float v) { v = sum8(v); v += dpp_f(v, 3); v = xsum16(v); return xsum32(v); }
__device__ __forceinline__ float sigmoidf(float x) { return __builtin_amdgcn_rcpf(1.f + __builtin_amdgcn_exp2f(-x * LOG2E)); }
__device__ __forceinline__ float siluf(float x) { return x * sigmoidf(x); }
}

namespace pg8 {
constexpr int BM = 256, BK = 64, HALF = 128, HTB = HALF * BK * 2, STAGE_BYTES = 8 * HTB, NXCD = 8, WGM = 8;
__host__ __device__ __forceinline__ int lds_byte(int r, int c) { const int st = (r >> 4) * 2 + (c >> 5), rr = r & 15, cc = c & 31, ob = rr * 64 + cc * 2; return st * 1024 + (ob ^ (((ob >> 9) & 1) << 5)); }
__host__ __device__ __forceinline__ void stage_rc(int b, int& R, int& C) { const int st = b / 1024, sb = b % 1024, swz = sb ^ (((sb >> 9) & 1) << 5); R = (st >> 1) * 16 + swz / 64; C = (st & 1) * 32 + (swz % 64) / 2; }
__host__ __device__ __forceinline__ int perm32(int rho) { const int n = rho >> 4, i = rho & 15; return 8 * (i >> 2) + 4 * n + (i & 3); }

struct Unit { int pm, pn; const char* A; const char* B; int tag; int r0, rend, y0; };
__device__ __forceinline__ const char* uni_ptr(const char* p) { const unsigned long long v = (unsigned long long)p; const unsigned lo = __builtin_amdgcn_readfirstlane((unsigned)v), hi = __builtin_amdgcn_readfirstlane((unsigned)(v >> 32)); return (const char*)(((unsigned long long)hi << 32) | lo); }
struct Cfg { unsigned lda, ldb; int K; };

__device__ __forceinline__ bool static_tile(int i, int G, int c, int nM, int nN, int& pm, int& pn) {
    const int nwg = nM * nN; const long L = (long)i * G + c; if (L >= nwg) return false;
    int wgid = (int)L; { const int q = nwg / NXCD, r = nwg % NXCD, xcd = wgid % NXCD, off = wgid / NXCD; wgid = (xcd < r ? xcd * (q + 1) : r * (q + 1) + (xcd - r) * q) + off; }
    const int nig = WGM * nN, gid = wgid / nig, fm = gid * WGM, gsz = (nM - fm) < WGM ? (nM - fm) : WGM;
    pm = fm + ((wgid % nig) % gsz); pn = (wgid % nig) / gsz; return true;
}
struct DenseSched {
    int nM, nN, G, c; const char* A; const char* B; size_t tA, tB;
    __device__ __forceinline__ bool next(int i, Unit& u) const { if (!static_tile(i, G, c, nM, nN, u.pm, u.pn)) return false; u.A = A + (size_t)u.pm * tA; u.B = B + (size_t)u.pn * tB; u.tag = 0; return true; }
    __device__ __forceinline__ int row(const Unit&, int r) const { return r; }
};

template <class Epi, class Sched, bool GATHER>
__device__ __forceinline__ void gemm_phase(LAS unsigned char* lds, const Cfg g, const Sched& S, const Epi& E, int wv_) {
    int tid_ = wv_ * 64 + mk::lane_id(); asm volatile("" : "+v"(tid_));
    const int tid = tid_, wid = __builtin_amdgcn_readfirstlane(tid >> 6), lane = tid & 63, wr = wid >> 2, wc = wid & 3, fr = lane & 15, fq = lane >> 4;
    const int nt = g.K / BK;
    int RA[2], CA2[2]; unsigned vB[2], vAc[2][2], vAn[2][2];
#pragma unroll
    for (int i = 0; i < 2; ++i) { int R, C; stage_rc(tid * 16 + i * 8192, R, C); const int Rb = Epi::PERM ? (64 * (R >> 5) + 16 * ((R & 15) >> 2) + 4 * ((R >> 4) & 1) + (R & 3)) : R;
        RA[i] = R; CA2[i] = C * 2; vB[i] = (unsigned)Rb * g.ldb + (unsigned)C * 2u; }
    const size_t kstep = (size_t)(BK * 2);
    const size_t hB = (size_t)(Epi::PERM ? 8 : HALF) * g.ldb;
    const unsigned ldsw = (unsigned)wid * 1024u;
    const int aoff = lds_byte(wr * 64 + fr, fq * 8), boff = lds_byte(wc * 32 + fr, fq * 8);
#define PG8_SA(b, h) (((b) * 2 + (h)) * HTB)
#define PG8_SB(b, h) ((4 + (b) * 2 + (h)) * HTB)
#define PG8_STAGE(bufoff, gbase, voff) do { const char* _gb = uni_ptr((const char*)(gbase)); _Pragma("unroll") for (int _i = 0; _i < 2; ++_i) \
        __builtin_amdgcn_global_load_lds((const unsigned*)(_gb + (voff)[_i]), (LAS unsigned*)(lds + (bufoff) + ldsw + _i * 8192), 16, 0, 0); } while (0)
#define PG8_LDA(dst, b, h) do { _Pragma("unroll") for (int m = 0; m < 4; ++m) _Pragma("unroll") for (int k = 0; k < 2; ++k) dst[m][k] = *(const LAS bf16x8*)(lds + PG8_SA(b, h) + aoff + m * 2048 + k * 1024); } while (0)
#define PG8_LDB(dst, b, h) do { _Pragma("unroll") for (int n = 0; n < 2; ++n) _Pragma("unroll") for (int k = 0; k < 2; ++k) dst[n][k] = *(const LAS bf16x8*)(lds + PG8_SB(b, h) + boff + n * 2048 + k * 1024); } while (0)
#define PG8_MMA(ai, bj, At, Bt) do { __builtin_amdgcn_s_setprio(1); _Pragma("unroll") for (int m = 0; m < 4; ++m) _Pragma("unroll") for (int n = 0; n < 2; ++n) _Pragma("unroll") for (int k = 0; k < 2; ++k) \
        acc[ai][bj][m][n] = __builtin_amdgcn_mfma_f32_16x16x32_bf16(Bt[n][k], At[m][k], acc[ai][bj][m][n], 0, 0, 0); __builtin_amdgcn_s_setprio(0); } while (0)
#define PG8_WAIT_V(n) asm volatile("s_waitcnt vmcnt(" #n ")" ::: "memory")
#define PG8_WAIT_L(n) asm volatile("s_waitcnt lgkmcnt(" #n ")" ::: "memory")
#define PG8_BAR __builtin_amdgcn_s_barrier()
#define PG8_SCHED __builtin_amdgcn_sched_barrier(0)
#define PG8_VOFF(dst, u) do { _Pragma("unroll") for (int _h = 0; _h < 2; ++_h) _Pragma("unroll") for (int _i = 0; _i < 2; ++_i) \
        dst[_h][_i] = (unsigned)S.row(u, _h * HALF + RA[_i]) * g.lda + (unsigned)CA2[_i]; } while (0)
    Unit cur, nxt; int ui = 0;
    if (!S.next(0, cur)) return;
    f32x4 acc[2][2][4][2];
#pragma unroll
    for (int a = 0; a < 2; ++a)
#pragma unroll
        for (int b = 0; b < 2; ++b)
#pragma unroll
            for (int m = 0; m < 4; ++m)
#pragma unroll
                for (int n = 0; n < 2; ++n) acc[a][b][m][n] = (f32x4){0.f, 0.f, 0.f, 0.f};
    bf16x8 At[4][2], B0[2][2], B1[2][2];
    const char* cA = uni_ptr(cur.A); const char* cB = uni_ptr(cur.B);
    PG8_VOFF(vAc, cur);
    PG8_STAGE(PG8_SB(0, 0), cB, vB); PG8_STAGE(PG8_SB(0, 1), cB + hB, vB); PG8_STAGE(PG8_SA(0, 0), cA, vAc[0]); PG8_STAGE(PG8_SA(0, 1), cA, vAc[1]);
    if (wr == 1) PG8_BAR;
    PG8_WAIT_V(2); PG8_BAR;
    PG8_STAGE(PG8_SB(1, 0), cB + kstep, vB); PG8_STAGE(PG8_SA(1, 0), cA + kstep, vAc[0]); PG8_STAGE(PG8_SB(1, 1), cB + hB + kstep, vB);
    PG8_WAIT_V(6); PG8_BAR;
    for (;;) {
        const bool has_next = S.next(ui + 1, nxt);
        const char* nA = uni_ptr(has_next ? nxt.A : cA); const char* nB = uni_ptr(has_next ? nxt.B : cB);
        if constexpr (GATHER) { if (has_next) { PG8_VOFF(vAn, nxt); } else {
#pragma unroll
            for (int _h = 0; _h < 2; ++_h)
#pragma unroll
                for (int _i = 0; _i < 2; ++_i) vAn[_h][_i] = vAc[_h][_i]; } }
        for (int t = 0; t < nt; t += 2) {
            const bool last = (t == nt - 2);
            asm volatile("" : "+v"(vB[0]), "+v"(vB[1]), "+v"(vAc[0][0]), "+v"(vAc[0][1]), "+v"(vAc[1][0]), "+v"(vAc[1][1]));
            const char* a1 = cA + (size_t)(t + 1) * kstep;
            const char* a2 = uni_ptr(last ? nA : cA + (size_t)(t + 2) * kstep); const char* b2 = uni_ptr(last ? nB : cB + (size_t)(t + 2) * kstep);
            const char* a3 = a2 + kstep; const char* b3 = b2 + kstep;
            unsigned w0[2], w1[2];
#pragma unroll
            for (int _i = 0; _i < 2; ++_i) { if constexpr (GATHER) { w0[_i] = last ? vAn[0][_i] : vAc[0][_i]; w1[_i] = last ? vAn[1][_i] : vAc[1][_i]; } else { w0[_i] = vAc[0][_i]; w1[_i] = vAc[1][_i]; } }
            PG8_LDB(B0, 0, 0); PG8_LDB(B1, 0, 1); PG8_SCHED; PG8_LDA(At, 0, 0); PG8_STAGE(PG8_SA(1, 1), a1, vAc[1]);
            PG8_WAIT_V(8); PG8_WAIT_L(0); PG8_BAR; PG8_MMA(0, 0, At, B0); PG8_MMA(0, 1, At, B1); PG8_BAR; PG8_SCHED;
            PG8_LDA(At, 0, 1); PG8_STAGE(PG8_SB(0, 0), b2, vB); PG8_STAGE(PG8_SB(0, 1), b2 + hB, vB); PG8_STAGE(PG8_SA(0, 0), a2, w0);
            PG8_WAIT_V(8); PG8_WAIT_L(0); PG8_BAR; PG8_MMA(1, 0, At, B0); PG8_MMA(1, 1, At, B1); PG8_BAR; PG8_SCHED;
            PG8_LDB(B0, 1, 0); PG8_LDB(B1, 1, 1); PG8_SCHED; PG8_LDA(At, 1, 0); PG8_STAGE(PG8_SA(0, 1), a2, w1);
            PG8_WAIT_V(8); PG8_WAIT_L(0); PG8_BAR; PG8_MMA(0, 0, At, B0); PG8_MMA(0, 1, At, B1); PG8_BAR; PG8_SCHED;
            PG8_LDA(At, 1, 1); PG8_STAGE(PG8_SB(1, 0), b3, vB); PG8_STAGE(PG8_SB(1, 1), b3 + hB, vB); PG8_STAGE(PG8_SA(1, 0), a3, w0);
            PG8_WAIT_V(8); PG8_WAIT_L(0); PG8_BAR; PG8_MMA(1, 0, At, B0); PG8_MMA(1, 1, At, B1); PG8_BAR; PG8_SCHED;
        }
        if (wr == 0) PG8_BAR;
        const bool keep = E(acc, cur, wr, wc, fr, fq);
        if (!has_next) break;
        if (!keep) {
#pragma unroll
            for (int a = 0; a < 2; ++a)
#pragma unroll
                for (int b = 0; b < 2; ++b)
#pragma unroll
                    for (int m = 0; m < 4; ++m)
#pragma unroll
                        for (int n = 0; n < 2; ++n) acc[a][b][m][n] = (f32x4){0.f, 0.f, 0.f, 0.f};
        }
        cur = nxt; cA = nA; cB = nB; ++ui;
        if constexpr (GATHER) {
#pragma unroll
            for (int _h = 0; _h < 2; ++_h)
#pragma unroll
                for (int _i = 0; _i < 2; ++_i) vAc[_h][_i] = vAn[_h][_i]; }
        if (wr == 1) PG8_BAR;
    }
    PG8_WAIT_V(0);
    PG8_BAR;
#undef PG8_SA
#undef PG8_SB
#undef PG8_STAGE
#undef PG8_LDA
#undef PG8_LDB
#undef PG8_MMA
#undef PG8_WAIT_V
#undef PG8_WAIT_L
#undef PG8_BAR
#undef PG8_SCHED
#undef PG8_VOFF
}
}

namespace mk {
struct P {
    const float *x, *p, *g_mix, *w_in, *w_pool_mix, *pool_scale, *w_a, *q_gain, *k_gain, *sinks, *w_b, *w_gate, *b_gate, *w_out, *g_ffn, *w_router, *router_bias,
                *w_eg, *w_eu, *w_ed, *w_sg, *w_su, *w_sd, *g_ple, *w_pg, *w_pp, *g_post;
    float* out; char* ws;
};

struct RowBf { const bf16_t* base; int ld; __device__ __forceinline__ float4 load4(int r, int k) const { const uint2 v = *(const uint2*)(base + (size_t)r * ld + k);
    return make_float4(bf2f(v.x & 0xffffu), bf2f(v.x >> 16), bf2f(v.y & 0xffffu), bf2f(v.y >> 16)); } };
struct RowBfIdx { const bf16_t* base; int ld; const int* lst; int nvalid; int shift;
    __device__ __forceinline__ float4 load4(int r, int k) const { const int row = (r < nvalid ? lst[r] : lst[0]) >> shift; const uint2 v = *(const uint2*)(base + (size_t)row * ld + k);
    return make_float4(bf2f(v.x & 0xffffu), bf2f(v.x >> 16), bf2f(v.y & 0xffffu), bf2f(v.y >> 16)); } };
template <class ARow>
__device__ __forceinline__ void gemm_tile(int vt, ARow arow, const float* __restrict__ B, int ldb, int K, int n0, float (&acc)[4][4], float (*As)[68], float (*Bs)[64]) {
    const int tx = vt & 15, ty = vt >> 4;
#pragma unroll
    for (int i = 0; i < 4; ++i)
#pragma unroll
        for (int j = 0; j < 4; ++j) acc[i][j] = 0.f;
    const int ar = vt >> 2, ak = (vt & 3) * 4;
    const int bk = vt >> 4, bn = (vt & 15) * 4;
#pragma unroll 1
    for (int k0 = 0; k0 < K; k0 += 16) {
        const float4 av = arow.load4(ar, k0 + ak);
        const float4 bv = *(const float4*)(B + (size_t)(k0 + bk) * ldb + n0 + bn);
        __syncthreads();
        As[ak + 0][ar] = av.x; As[ak + 1][ar] = av.y; As[ak + 2][ar] = av.z; As[ak + 3][ar] = av.w;
        *(float4*)&Bs[bk][bn] = bv;
        __syncthreads();
#pragma unroll
        for (int kk = 0; kk < 16; ++kk) {
            const float4 a = *(const float4*)&As[kk][ty * 4];
            const float4 b = *(const float4*)&Bs[kk][tx * 4];
            const float aa[4] = {a.x, a.y, a.z, a.w}, bb[4] = {b.x, b.y, b.z, b.w};
#pragma unroll
            for (int i = 0; i < 4; ++i)
#pragma unroll
                for (int j = 0; j < 4; ++j) acc[i][j] += aa[i] * bb[j];
        }
    }
}
#define VB_LOOP(nvb) for (int _it = 0, _nit = ((nvb) + 2 * (int)gridDim.x - 1) / (2 * (int)gridDim.x); _it < _nit; ++_it) { \
    const int _raw = _it * 2 * (int)gridDim.x + (int)blockIdx.x * 2 + half; const bool vvalid = _raw < (nvb); const int vb = vvalid ? _raw : 0;
#define VB_END }
#define FOR_IJ _Pragma("unroll") for (int i = 0; i < 4; ++i) _Pragma("unroll") for (int j = 0; j < 4; ++j)

struct TItem { const float* src; int ld; bf16_t* dst; int ldk; const float* ks; int gu; };
__device__ __forceinline__ TItem ti_plain(const float* W, int K, int N, bf16_t* dstm, int row_off, int item, const float* kscale = nullptr) {
    const int nblk = N / 32, kb = item / nblk, nb = item % nblk;
    return TItem{W + (size_t)(64 * kb) * N + 32 * nb, N, dstm + (size_t)(row_off + 32 * nb) * K + 64 * kb, K, kscale ? kscale + 64 * kb : nullptr, 0}; }
__device__ __forceinline__ TItem ti_gu(const float* W, bf16_t* dstm, int up, int item, const float* kscale) {
    const int kb = item / 8, nb = item % 8, c0 = 32 * nb;
    return TItem{W + (size_t)(64 * kb) * 256 + c0, 256, dstm + (size_t)((c0 >> 7) * 256 + 2 * (c0 & 127) + 8 * up) * 1024 + 64 * kb, 1024, kscale + 64 * kb, 1}; }
__device__ __forceinline__ TItem ti_gate(const float* W, bf16_t* wcat, int item) {
    const int kb = item / 64, nb = item % 64, c0 = 32 * nb, ab = c0 >> 10, oc = c0 & 1023;
    return TItem{W + (size_t)(64 * kb) * (2 * D) + c0, 2 * D, wcat + (size_t)(IND + 256 * (oc >> 7) + 2 * (oc & 127) + 8 * ab) * D + 64 * kb, D, nullptr, 1}; }
__device__ __forceinline__ void ti_load(const TItem& t, f32x4 (&v)[8], int lane) {
#pragma unroll
    for (int i = 0; i < 8; ++i) { v[i] = *(const f32x4*)(t.src + (size_t)(8 * (lane >> 3) + i) * t.ld + 4 * (lane & 7)); if (t.ks) v[i] = v[i] * t.ks[8 * (lane >> 3) + i]; } }
__device__ __forceinline__ void ti_finish(const TItem& t, const f32x4 (&v)[8], LAS float*, int lane) {
#pragma unroll
    for (int j = 0; j < 4; ++j) { u32x4 o; o.x = pk2(v[0][j], v[1][j]); o.y = pk2(v[2][j], v[3][j]); o.z = pk2(v[4][j], v[5][j]); o.w = pk2(v[6][j], v[7][j]);
        const int n_ = 4 * (lane & 7) + j; *(u32x4*)(t.dst + (size_t)(t.gu ? 2 * (n_ & ~7) + (n_ & 7) : n_) * t.ldk + 8 * (lane >> 3)) = o; }
}

struct EpiG1 {
    static constexpr bool PERM = true;
    bf16_t* u; bf16_t* gates; const float* bg;
    __device__ __forceinline__ bool operator()(f32x4 (&acc)[2][2][4][2], const pg8::Unit& un, int wr, int wc, int fr, int fq) const {
        const int row0 = un.pm * 256 + wr * 64 + fr;
        if (un.pn < 5) { const int col0 = un.pn * 256 + wc * 64 + 16 * fq;
#pragma unroll
            for (int ai = 0; ai < 2; ++ai)
#pragma unroll
                for (int m = 0; m < 4; ++m) { bf16_t* rowp = u + (size_t)(row0 + ai * 128 + m * 16) * IND + col0;
#pragma unroll
                    for (int bj = 0; bj < 2; ++bj) { const f32x4 v0 = acc[ai][bj][m][0], v1 = acc[ai][bj][m][1];
                        u32x4 w; w.x = cvt_pk_bf16(v0[0], v0[1]); w.y = cvt_pk_bf16(v0[2], v0[3]); w.z = cvt_pk_bf16(v1[0], v1[1]); w.w = cvt_pk_bf16(v1[2], v1[3]);
                        *(u32x4*)(rowp + bj * 8) = w; } }
        } else { const int c0 = (un.pn - 5) * 128 + wc * 32 + 8 * fq;
            const f32x4 ba0 = *(const f32x4*)(bg + c0), ba1 = *(const f32x4*)(bg + c0 + 4), bb0 = *(const f32x4*)(bg + D + c0), bb1 = *(const f32x4*)(bg + D + c0 + 4);
#pragma unroll
            for (int ai = 0; ai < 2; ++ai)
#pragma unroll
                for (int m = 0; m < 4; ++m) { bf16_t* rowp = gates + (size_t)(row0 + ai * 128 + m * 16) * 2 * D + c0;
                    const f32x4 za0 = acc[ai][0][m][0] + ba0, za1 = acc[ai][0][m][1] + ba1, zb0 = acc[ai][1][m][0] + bb0, zb1 = acc[ai][1][m][1] + bb1;
                    f32x4 r0, r1, g0, g1;
#pragma unroll
                    for (int q = 0; q < 4; ++q) { g0[q] = sigmoidf(zb0[q]); g1[q] = sigmoidf(zb1[q]);
                        r0[q] = sigmoidf(za0[q]) * __builtin_amdgcn_rcpf(fmaxf(g0[q], 1e-12f)); r1[q] = sigmoidf(za1[q]) * __builtin_amdgcn_rcpf(fmaxf(g1[q], 1e-12f)); }
                    u32x4 w; w.x = cvt_pk_bf16(r0[0], r0[1]); w.y = cvt_pk_bf16(r0[2], r0[3]); w.z = cvt_pk_bf16(r1[0], r1[1]); w.w = cvt_pk_bf16(r1[2], r1[3]);
                    *(u32x4*)rowp = w;
                    w.x = cvt_pk_bf16(g0[0], g0[1]); w.y = cvt_pk_bf16(g0[2], g0[3]); w.z = cvt_pk_bf16(g1[0], g1[1]); w.w = cvt_pk_bf16(g1[2], g1[3]);
                    *(u32x4*)(rowp + D) = w; } }
        return false;
    }
};
struct EpiPP {
    static constexpr bool PERM = true;
    bf16_t* pp; float* rss;
    __device__ __forceinline__ bool operator()(f32x4 (&acc)[2][2][4][2], const pg8::Unit& un, int wr, int wc, int fr, int fq) const {
        const int row0 = un.pm * 256 + wr * 64 + fr, col0 = un.pn * 256 + wc * 64 + 16 * fq;
#pragma unroll
        for (int ai = 0; ai < 2; ++ai)
#pragma unroll
            for (int m = 0; m < 4; ++m) { const int row = row0 + ai * 128 + m * 16; bf16_t* rowp = pp + (size_t)row * D + col0; float s = 0.f;
#pragma unroll
                for (int bj = 0; bj < 2; ++bj) { const f32x4 v0 = acc[ai][bj][m][0], v1 = acc[ai][bj][m][1];
                    s += (v0[0] * v0[0] + v0[1] * v0[1]) + (v0[2] * v0[2] + v0[3] * v0[3]) + (v1[0] * v1[0] + v1[1] * v1[1]) + (v1[2] * v1[2] + v1[3] * v1[3]);
                    u32x4 w; w.x = cvt_pk_bf16(v0[0], v0[1]); w.y = cvt_pk_bf16(v0[2], v0[3]); w.z = cvt_pk_bf16(v1[0], v1[1]); w.w = cvt_pk_bf16(v1[2], v1[3]);
                    *(u32x4*)(rowp + bj * 8) = w; }
                s = xsum32(xsum16(s));
                if (fq == 0) atomicAdd(rss + row, s); }
        return false;
    }
};


struct EpiBf16Plain {
    static constexpr bool PERM = true;
    bf16_t* O; int ld;
    __device__ __forceinline__ bool operator()(f32x4 (&acc)[2][2][4][2], const pg8::Unit& un, int wr, int wc, int fr, int fq) const {
        const int row0 = un.pm * 256 + wr * 64 + fr, col0 = un.pn * 256 + wc * 64 + 16 * fq;
#pragma unroll
        for (int ai = 0; ai < 2; ++ai)
#pragma unroll
            for (int m = 0; m < 4; ++m) { bf16_t* rowp = O + (size_t)(row0 + ai * 128 + m * 16) * ld + col0;
#pragma unroll
                for (int bj = 0; bj < 2; ++bj) { const f32x4 v0 = acc[ai][bj][m][0], v1 = acc[ai][bj][m][1];
                    u32x4 w; w.x = cvt_pk_bf16(v0[0], v0[1]); w.y = cvt_pk_bf16(v0[2], v0[3]); w.z = cvt_pk_bf16(v1[0], v1[1]); w.w = cvt_pk_bf16(v1[2], v1[3]);
                    *(u32x4*)(rowp + bj * 8) = w; } }
        return false;
    }
};
struct PPSched {
    int G, c; const char* A; const char* B;
    __device__ __forceinline__ bool next(int i, pg8::Unit& u) const {
        if (G != 256) { if (!pg8::static_tile(i, G, c, T / 256, D / 256, u.pm, u.pn)) return false; }
        else { int idx; if (c < 128) { if (i > 0) return false; idx = c; } else { if (i > 2) return false; idx = 128 + (c - 128) * 3 + i; } u.pm = idx >> 2; u.pn = idx & 3; }
        u.A = A + (size_t)u.pm * 256 * PLE * 2; u.B = B + (size_t)u.pn * 256 * PLE * 2; u.tag = 0; return true; }
    __device__ __forceinline__ int row(const pg8::Unit&, int r) const { return r; }
};
struct P6Sched {
    int G, c; const char* A; const char* B;
    __device__ __forceinline__ bool next(int i, pg8::Unit& u) const {
        if (G != 256) { if (!pg8::static_tile(i, G, c, T / 256, 3, u.pm, u.pn)) return false; }
        else if (c < 128) { if (i > 0) return false; u.pm = c; u.pn = 2; }
        else { if (i > 1) return false; const int idx = (c - 128) * 2 + i; u.pm = idx >> 1; u.pn = idx & 1; }
        u.A = A + (size_t)u.pm * 256 * D * 2; u.B = B + (size_t)u.pn * 256 * D * 2; u.tag = 0; return true; }
    __device__ __forceinline__ int row(const pg8::Unit&, int r) const { return r; }
};
struct MixSched {
    int G, c; const char* A; const char* B;
    __device__ __forceinline__ bool next(int i, pg8::Unit& u) const { if (!pg8::static_tile(i, G, c, T / 256, 2, u.pm, u.pn)) return false;
        u.A = A + (size_t)u.pm * 256 * POOLD * 2 + (size_t)u.pn * 512; u.B = B + (size_t)u.pn * 256 * 256 * 2; u.tag = 0; return true; }
    __device__ __forceinline__ int row(const pg8::Unit&, int r) const { return r; }
};
struct MergedSched {
    int G, c; const char* A0; const char* A1; const char* B0; const char* B1;
    __device__ __forceinline__ bool next(int i, pg8::Unit& u) const { if (!pg8::static_tile(i >> 1, G, c, T / 256, D / 256, u.pm, u.pn)) return false;
        const int br = i & 1; u.A = (br ? A1 : A0) + (size_t)u.pm * 256 * 512 * 2; u.B = (br ? B1 : B0) + (size_t)u.pn * 256 * 512 * 2; u.tag = br; return true; }
    __device__ __forceinline__ int row(const pg8::Unit&, int r) const { return r; }
};
struct EpiMerged {
    static constexpr bool PERM = true;
    const bf16_t* gates; bf16_t* O;
    __device__ __forceinline__ bool operator()(f32x4 (&acc)[2][2][4][2], const pg8::Unit& un, int wr, int wc, int fr, int fq) const {
        const int row0 = un.pm * 256 + wr * 64 + fr, col0 = un.pn * 256 + wc * 64 + 16 * fq;
#pragma unroll
        for (int ai = 0; ai < 2; ++ai)
#pragma unroll
            for (int m = 0; m < 4; ++m) { const size_t row = (size_t)(row0 + ai * 128 + m * 16);
#pragma unroll
                for (int bj = 0; bj < 2; ++bj) { const u32x4 gv = *(const u32x4*)(gates + row * 2 * D + (un.tag == 0 ? 0 : D) + col0 + bj * 8);
                    const float gf[8] = {bf2f(gv.x & 0xffffu), bf2f(gv.x >> 16), bf2f(gv.y & 0xffffu), bf2f(gv.y >> 16), bf2f(gv.z & 0xffffu), bf2f(gv.z >> 16), bf2f(gv.w & 0xffffu), bf2f(gv.w >> 16)};
                    if (un.tag == 0) {
#pragma unroll
                        for (int q = 0; q < 4; ++q) { acc[ai][bj][m][0][q] *= gf[q]; acc[ai][bj][m][1][q] *= gf[4 + q]; }
                    } else { const f32x4 v0 = acc[ai][bj][m][0], v1 = acc[ai][bj][m][1];
                        u32x4 w; w.x = cvt_pk_bf16(v0[0] * gf[0], v0[1] * gf[1]); w.y = cvt_pk_bf16(v0[2] * gf[2], v0[3] * gf[3]); w.z = cvt_pk_bf16(v1[0] * gf[4], v1[1] * gf[5]); w.w = cvt_pk_bf16(v1[2] * gf[6], v1[3] * gf[7]);
                        *(u32x4*)(O + row * D + col0 + bj * 8) = w; } } }
        return un.tag == 0;
    }
};
struct EpiResid {
    static constexpr bool PERM = true;
    const float* x; bf16_t* xb; float* rss;
    __device__ __forceinline__ bool operator()(f32x4 (&acc)[2][2][4][2], const pg8::Unit& un, int wr, int wc, int fr, int fq) const {
        const int row0 = un.pm * 256 + wr * 64 + fr, col0 = un.pn * 256 + wc * 64 + 16 * fq;
#pragma unroll
        for (int ai = 0; ai < 2; ++ai)
#pragma unroll
            for (int m = 0; m < 4; ++m) { const int row = row0 + ai * 128 + m * 16; const size_t off = (size_t)row * D + col0; float s = 0.f;
#pragma unroll
                for (int bj = 0; bj < 2; ++bj) { const f32x4 v0 = *(const f32x4*)(x + off + bj * 8) + acc[ai][bj][m][0], v1 = *(const f32x4*)(x + off + bj * 8 + 4) + acc[ai][bj][m][1];
                    s += (v0[0] * v0[0] + v0[1] * v0[1]) + (v0[2] * v0[2] + v0[3] * v0[3]) + (v1[0] * v1[0] + v1[1] * v1[1]) + (v1[2] * v1[2] + v1[3] * v1[3]);
                    u32x4 w; w.x = cvt_pk_bf16(v0[0], v0[1]); w.y = cvt_pk_bf16(v0[2], v0[3]); w.z = cvt_pk_bf16(v1[0], v1[1]); w.w = cvt_pk_bf16(v1[2], v1[3]);
                    *(u32x4*)(xb + off + bj * 8) = w; }
                s = xsum32(xsum16(s));
                if (fq == 0) atomicAdd(rss + row, s); }
        return false;
    }
};
struct EpiShared {
    static constexpr bool PERM = true;
    bf16_t* act; float* lg; const float* rss;
    __device__ __forceinline__ bool operator()(f32x4 (&acc)[2][2][4][2], const pg8::Unit& un, int wr, int wc, int fr, int fq) const {
        const int row0 = un.pm * 256 + wr * 64 + fr;
#pragma unroll
        for (int ai = 0; ai < 2; ++ai)
#pragma unroll
            for (int m = 0; m < 4; ++m) { const int row = row0 + ai * 128 + m * 16; const float rs = rsqrtf(rss[row] * (1.f / D) + EPS);
                if (un.pn < 2) { const f32x4 g0 = acc[ai][0][m][0] * rs, g1 = acc[ai][0][m][1] * rs, u0 = acc[ai][1][m][0] * rs, u1 = acc[ai][1][m][1] * rs;
                    u32x4 w; w.x = cvt_pk_bf16(siluf(g0[0]) * u0[0], siluf(g0[1]) * u0[1]); w.y = cvt_pk_bf16(siluf(g0[2]) * u0[2], siluf(g0[3]) * u0[3]);
                    w.z = cvt_pk_bf16(siluf(g1[0]) * u1[0], siluf(g1[1]) * u1[1]); w.w = cvt_pk_bf16(siluf(g1[2]) * u1[2], siluf(g1[3]) * u1[3]);
                    *(u32x4*)(act + (size_t)row * SD + un.pn * 128 + wc * 32 + 8 * fq) = w;
                } else if (wc == 0) { float* lp = lg + (size_t)row * NE + 16 * fq;
                    *(f32x4*)lp = acc[ai][0][m][0] * rs; *(f32x4*)(lp + 4) = acc[ai][0][m][1] * rs; *(f32x4*)(lp + 8) = acc[ai][1][m][0] * rs; *(f32x4*)(lp + 12) = acc[ai][1][m][1] * rs; } }
        return false;
    }
};
struct EpiFinal {
    static constexpr bool PERM = true;
    float* o; const bf16_t* x2; const bf16_t* pp; const float* rss3_; const float* rsspp_; const float* gp;
    __device__ __forceinline__ bool operator()(f32x4 (&acc)[2][2][4][2], const pg8::Unit& un, int wr, int wc, int fr, int fq) const {
        const int row0 = un.pm * 256 + wr * 64 + fr, col0 = un.pn * 256 + wc * 64 + 16 * fq;
        f32x4 gv[2][2];
#pragma unroll
        for (int bj = 0; bj < 2; ++bj)
#pragma unroll
            for (int n = 0; n < 2; ++n) gv[bj][n] = *(const f32x4*)(gp + col0 + bj * 8 + n * 4);
#pragma unroll
        for (int ai = 0; ai < 2; ++ai)
#pragma unroll
            for (int m = 0; m < 4; ++m) { const int row = row0 + ai * 128 + m * 16; const size_t off = (size_t)row * D + col0;
                const float r3 = rsqrtf(rss3_[row] * (1.f / D) + EPS), rp = rsqrtf(rsspp_[row] * (1.f / D) + EPS);
#pragma unroll
                for (int bj = 0; bj < 2; ++bj) { const size_t o2 = off + bj * 8; const u32x4 xv = *(const u32x4*)(x2 + o2), pv = *(const u32x4*)(pp + o2);
                    const f32x4 a0 = acc[ai][bj][m][0] * r3, a1 = acc[ai][bj][m][1] * r3; f32x4 v0, v1;
                    v0[0] = bf2f(xv.x & 0xffffu) + sigmoidf(a0[0]) * bf2f(pv.x & 0xffffu) * rp * gv[bj][0][0]; v0[1] = bf2f(xv.x >> 16) + sigmoidf(a0[1]) * bf2f(pv.x >> 16) * rp * gv[bj][0][1];
                    v0[2] = bf2f(xv.y & 0xffffu) + sigmoidf(a0[2]) * bf2f(pv.y & 0xffffu) * rp * gv[bj][0][2]; v0[3] = bf2f(xv.y >> 16) + sigmoidf(a0[3]) * bf2f(pv.y >> 16) * rp * gv[bj][0][3];
                    v1[0] = bf2f(xv.z & 0xffffu) + sigmoidf(a1[0]) * bf2f(pv.z & 0xffffu) * rp * gv[bj][1][0]; v1[1] = bf2f(xv.z >> 16) + sigmoidf(a1[1]) * bf2f(pv.z >> 16) * rp * gv[bj][1][1];
                    v1[2] = bf2f(xv.w & 0xffffu) + sigmoidf(a1[2]) * bf2f(pv.w & 0xffffu) * rp * gv[bj][1][2]; v1[3] = bf2f(xv.w >> 16) + sigmoidf(a1[3]) * bf2f(pv.w >> 16) * rp * gv[bj][1][3];
                    *(f32x4*)(o + o2) = v0; *(f32x4*)(o + o2 + 4) = v1; } }
        return false;
    }
};
__device__ __forceinline__ int find_expert(const LAS int* mts, int mt) { int e = 0;
#pragma unroll 1
    for (; e < NE - 1; ++e) if (mt < mts[e + 1]) break;
    return e; }
struct RoutedUpSched {
    int G, c, nM; const LAS unsigned char* t2e; const int* tl; const char* A; const char* B;
    __device__ __forceinline__ bool next(int i, pg8::Unit& u) const { if (!pg8::static_tile(i, G, c, nM, 2, u.pm, u.pn)) return false;
        const int e = t2e[u.pm]; u.A = A; u.B = B + (size_t)e * 512 * D * 2 + (size_t)u.pn * 256 * D * 2; u.tag = e; return true; }
    __device__ __forceinline__ int row(const pg8::Unit& u, int r) const { const int aid = tl[u.pm * 256 + r]; return aid < 0 ? 0 : (aid >> 3); }
};
struct EpiRoutedUp {
    static constexpr bool PERM = true;
    bf16_t* act; const int2* ri; const float* wt;
    __device__ __forceinline__ bool operator()(f32x4 (&acc)[2][2][4][2], const pg8::Unit& un, int wr, int wc, int fr, int fq) const {
        const int row0 = un.pm * 256 + wr * 64 + fr;
#pragma unroll
        for (int ai = 0; ai < 2; ++ai)
#pragma unroll
            for (int m = 0; m < 4; ++m) { const int pos = row0 + ai * 128 + m * 16; const int2 inf = ri[pos];
                const float rs = __int_as_float(inf.y), w = wt[pos];
                const f32x4 g0 = acc[ai][0][m][0] * rs, g1 = acc[ai][0][m][1] * rs, u0 = acc[ai][1][m][0] * (rs * w), u1 = acc[ai][1][m][1] * (rs * w);
                u32x4 o; o.x = cvt_pk_bf16(siluf(g0[0]) * u0[0], siluf(g0[1]) * u0[1]); o.y = cvt_pk_bf16(siluf(g0[2]) * u0[2], siluf(g0[3]) * u0[3]);
                o.z = cvt_pk_bf16(siluf(g1[0]) * u1[0], siluf(g1[1]) * u1[1]); o.w = cvt_pk_bf16(siluf(g1[2]) * u1[2], siluf(g1[3]) * u1[3]);
                *(u32x4*)(act + (size_t)pos * ED + un.pn * 128 + wc * 32 + 8 * fq) = o; }
        return false;
    }
};
struct DownSched {
    int G, c, r; const LAS int* lo; const LAS int* tst; const LAS unsigned char* t2e; const LAS int* cb; const char* Ar; const char* As_; const char* Br; const char* Bs_;
    __device__ __forceinline__ bool next(int i, pg8::Unit& u) const { const LAS int* ts = tst + r * 65; const int ntl = ts[64];
        if (!pg8::static_tile(i, G, c, ntl + TR / 256, 4, u.pm, u.pn)) return false;
        if (u.pm < ntl) { const int e = t2e[r * T2S + u.pm]; const int row0 = lo[r * 64 + e] + 256 * (u.pm - ts[e]);
            u.A = Ar + (size_t)row0 * ED * 2; u.B = Br + (size_t)e * D * ED * 2 + (size_t)u.pn * 256 * ED * 2; u.tag = 0; u.r0 = row0; u.rend = lo[(r + 1) * 64 + e]; u.y0 = cb[r * 64 + e] + 256 * (u.pm - ts[e]); }
        else { const int t0 = r * TR + 256 * (u.pm - ntl); u.A = As_ + (size_t)t0 * SD * 2; u.B = Bs_ + (size_t)u.pn * 256 * SD * 2; u.tag = 1; u.r0 = t0; u.rend = t0 + 256; u.y0 = 8 * TR + 256 * (u.pm - ntl); }
        return true; }
    __device__ __forceinline__ int row(const pg8::Unit&, int r_) const { return r_; }
};
__device__ __forceinline__ unsigned pack_fp8x4(f32x4 v) {
    const float a0 = __builtin_amdgcn_fmed3f(v[0], -448.f, 448.f), a1 = __builtin_amdgcn_fmed3f(v[1], -448.f, 448.f), a2 = __builtin_amdgcn_fmed3f(v[2], -448.f, 448.f), a3 = __builtin_amdgcn_fmed3f(v[3], -448.f, 448.f);
    int w = __builtin_amdgcn_cvt_pk_fp8_f32(a0, a1, 0, false); w = __builtin_amdgcn_cvt_pk_fp8_f32(a2, a3, w, true); return (unsigned)w; }
struct EpiDown {
    static constexpr bool PERM = true;
    unsigned char* Y;
    __device__ __forceinline__ bool operator()(f32x4 (&acc)[2][2][4][2], const pg8::Unit& un, int wr, int wc, int fr, int fq) const {
        const int rl0 = wr * 64 + fr;
#pragma unroll
        for (int ai = 0; ai < 2; ++ai)
#pragma unroll
            for (int m = 0; m < 4; ++m) { const int rl = rl0 + ai * 128 + m * 16;
                if (un.r0 + rl < un.rend) { unsigned char* yr = Y + (size_t)(un.y0 + rl) * 1024 + un.pn * 256 + wc * 64 + 16 * fq;
                    u32x4 o; o.x = pack_fp8x4(acc[ai][0][m][0]); o.y = pack_fp8x4(acc[ai][0][m][1]); o.z = pack_fp8x4(acc[ai][1][m][0]); o.w = pack_fp8x4(acc[ai][1][m][1]); *(u32x4*)yr = o; } }
        return false;
    }
};

#define XB_TMO      128
#define XB_XCNT(j)  (256  + 64 * (j))
#define XB_XSUB(j)  (1280 + 64 * (j))
#define XB_XGEN(j)  (2304 + 64 * (j))
#define XB_TOP      3328
#define XB_TOPGEN   3392
#define XCD_BAR_WORDS 3456
#define XB_SPIN_CAP (1u << 22)
__device__ __forceinline__ unsigned xb_ld(unsigned* p)              { return __hip_atomic_load(p, __ATOMIC_RELAXED, __HIP_MEMORY_SCOPE_AGENT); }
__device__ __forceinline__ unsigned xb_add(unsigned* p, unsigned v) { return __hip_atomic_fetch_add(p, v, __ATOMIC_RELAXED, __HIP_MEMORY_SCOPE_AGENT); }
__device__ __forceinline__ unsigned xb_xcc_id() { return (unsigned)__builtin_amdgcn_s_getreg((3 << 11) | 20) & 0xFu; }
#define XB_SPIN(cond, bar) do { unsigned _sp = 0; while (cond) { __builtin_amdgcn_s_sleep(1); \
    if ((++_sp & 255u) == 0u) { if (xb_ld(&(bar)[XB_TMO])) break; if (_sp > XB_SPIN_CAP) { atomicAdd(&(bar)[XB_TMO], 1u); break; } } } } while (0)
struct XcdBarrier { unsigned* bar; unsigned x; volatile LAS unsigned* st; };
__device__ __forceinline__ XcdBarrier xcd_barrier_post(unsigned* bar, volatile LAS unsigned* st, bool first_wave) {
    XcdBarrier b; b.bar = bar; b.x = xb_xcc_id(); b.st = st;
    if (lane_id() == 0 && first_wave) (void)xb_add(&bar[XB_XCNT(b.x)], 1u);
    return b;
}
__device__ __forceinline__ void xcd_barrier_complete(unsigned* bar, unsigned x, unsigned& nloc, unsigned& nx) {
    const unsigned G = gridDim.x * gridDim.y * gridDim.z;
    unsigned sum, cnt, mine, sp = 0u;
    for (;;) {
        sum = 0u; cnt = 0u; mine = 0u;
#pragma unroll
        for (unsigned j = 0; j < 16; ++j) { const unsigned c = xb_ld(&bar[XB_XCNT(j)]); sum += c; cnt += (c > 0u) ? 1u : 0u; mine = (j == x) ? c : mine; }
        if (sum == G) break;
        __builtin_amdgcn_s_sleep(1);
        if ((++sp & 255u) == 0u) { if (xb_ld(&bar[XB_TMO])) break; if (sp > XB_SPIN_CAP) { atomicAdd(&bar[XB_TMO], 1u); break; } }
    }
    nloc = mine > 0u ? mine : 1u; nx = cnt > 0u ? cnt : 1u;
}
__device__ __forceinline__ void xcd_barrier(const XcdBarrier& b, int tid) {
    asm volatile("s_waitcnt vmcnt(0)" ::: "memory");
    __syncthreads();
    if (tid == 0) {
        unsigned* bar = b.bar; unsigned bx = b.x; asm volatile("" : "+s"(bx));
        __builtin_amdgcn_s_waitcnt(0);
        unsigned nloc = b.st[0], nx = b.st[1];
        if (nloc == 0u) { xcd_barrier_complete(bar, bx, nloc, nx); b.st[0] = nloc; b.st[1] = nx; }
        const unsigned old = xb_add(&bar[XB_XSUB(bx)], 1u);
        const unsigned gen = old / nloc;
        if (old + 1u == (gen + 1u) * nloc) {
            __builtin_amdgcn_fence(__ATOMIC_RELEASE, "agent");
            asm volatile("s_waitcnt vmcnt(0)" ::: "memory");
            const unsigned og = xb_add(&bar[XB_TOP], 1u);
            const unsigned tg = og / nx;
            if (og + 1u == (tg + 1u) * nx) xb_add(&bar[XB_TOPGEN], 1u);
            else XB_SPIN(xb_ld(&bar[XB_TOPGEN]) == tg, bar);
            __builtin_amdgcn_fence(__ATOMIC_ACQUIRE, "agent");
            xb_add(&bar[XB_XGEN(bx)], 1u);
            asm volatile("s_waitcnt vmcnt(0)" ::: "memory");
        } else {
            XB_SPIN(xb_ld(&bar[XB_XGEN(bx)]) == gen, bar);
            __builtin_amdgcn_fence(__ATOMIC_ACQUIRE, "agent");
            asm volatile("s_waitcnt vmcnt(0)" ::: "memory");
        }
    }
    __syncthreads();
}

typedef float f32x16 __attribute__((ext_vector_type(16)));
typedef short s16x4 __attribute__((ext_vector_type(4)));
__device__ __forceinline__ void attn_phase(LAS unsigned char* lds, const bf16_t* __restrict__ u, bf16_t* __restrict__ attn, const float* __restrict__ sinks, const float* __restrict__ qg, const float* __restrict__ kg, int G, int wv_) {
    int tid_ = wv_ * 64 + lane_id(); asm volatile("" : "+v"(tid_));
    const int tid = tid_, lane = tid & 63, wave = __builtin_amdgcn_readfirstlane(tid >> 6), r32 = lane & 31, hi = lane >> 5;
    u32x4 kreg[4], vreg[4];
#define ATT_LOAD(un_) do { const int kvh_ = (un_) & 1, t0_ = ((un_) >> 1) * 128; _Pragma("unroll") for (int it = 0; it < 4; ++it) { const int i = tid + it * NT, j = i >> 3, ch = i & 7; int tok = t0_ - 128 + j; tok = tok < 0 ? 0 : tok; \
        kreg[it] = *(const u32x4*)(u + (size_t)tok * IND + POOLD + QD + kvh_ * 64 + ch * 8); vreg[it] = *(const u32x4*)(u + (size_t)tok * IND + POOLD + QD + KVD + kvh_ * 64 + ch * 8); } } while (0)
    if ((int)blockIdx.x < (T / 128) * 2) ATT_LOAD((int)blockIdx.x);
    for (int un = blockIdx.x; un < (T / 128) * 2; un += G) {
        const int kvh = un & 1, blk = un >> 1, t0 = blk * 128; const bool first = (t0 % SEQ) == 0;
#pragma unroll
        for (int it = 0; it < 4; ++it) { const int i = tid + it * NT, j = i >> 3, ch = i & 7;
            u32x4 kk = kreg[it]; const u32x4 vv = vreg[it];
            {
                float f[8] = {bf2f(kk.x & 0xffffu), bf2f(kk.x >> 16), bf2f(kk.y & 0xffffu), bf2f(kk.y >> 16), bf2f(kk.z & 0xffffu), bf2f(kk.z >> 16), bf2f(kk.w & 0xffffu), bf2f(kk.w >> 16)};
                float ss = 0.f;
#pragma unroll
                for (int q = 0; q < 8; ++q) ss += f[q] * f[q];
                ss = sum8(ss);
                const float r = rsqrtf(ss * (1.f / 64.f) + EPS); const float* gp = kg + 8 * ch;
                kk.x = pk2(f[0] * r * gp[0], f[1] * r * gp[1]); kk.y = pk2(f[2] * r * gp[2], f[3] * r * gp[3]); kk.z = pk2(f[4] * r * gp[4], f[5] * r * gp[5]); kk.w = pk2(f[6] * r * gp[6], f[7] * r * gp[7]); }
            *(LAS u32x4*)(lds + j * 128 + ((ch ^ (j & 7)) * 16)) = kk;
            *(LAS u32x4*)(lds + 32768 + j * 128 + ch * 16) = vv; }
        if (un + G < (T / 128) * 2) ATT_LOAD(un + G);
        __syncthreads();
#pragma unroll 1
        for (int task = wave; task < 16; task += 8) {
            const int hq = task & 3, rb = task >> 2, h = kvh * 4 + hq; const int tq = t0 + 32 * rb + r32;
            const float slope2 = exp2f(-(float)(h + 1)) * LOG2E, sink2 = sinks[h] * LOG2E;
            bf16x8 qf[4];
            {
                u32x4 qr[4]; float ss = 0.f;
#pragma unroll
                for (int ds = 0; ds < 4; ++ds) { qr[ds] = *(const u32x4*)(u + (size_t)tq * IND + POOLD + h * 64 + 16 * ds + 8 * hi);
                    const float f[8] = {bf2f(qr[ds].x & 0xffffu), bf2f(qr[ds].x >> 16), bf2f(qr[ds].y & 0xffffu), bf2f(qr[ds].y >> 16), bf2f(qr[ds].z & 0xffffu), bf2f(qr[ds].z >> 16), bf2f(qr[ds].w & 0xffffu), bf2f(qr[ds].w >> 16)};
#pragma unroll
                    for (int q = 0; q < 8; ++q) ss += f[q] * f[q]; }
                ss = xsum32(ss);
                const float r = rsqrtf(ss * (1.f / 64.f) + EPS) * (0.125f * LOG2E);
#pragma unroll
                for (int ds = 0; ds < 4; ++ds) { const float* gp = qg + 16 * ds + 8 * hi;
                    const float f[8] = {bf2f(qr[ds].x & 0xffffu), bf2f(qr[ds].x >> 16), bf2f(qr[ds].y & 0xffffu), bf2f(qr[ds].y >> 16), bf2f(qr[ds].z & 0xffffu), bf2f(qr[ds].z >> 16), bf2f(qr[ds].w & 0xffffu), bf2f(qr[ds].w >> 16)};
                    u32x4 w; w.x = pk2(f[0] * r * gp[0], f[1] * r * gp[1]); w.y = pk2(f[2] * r * gp[2], f[3] * r * gp[3]); w.z = pk2(f[4] * r * gp[4], f[5] * r * gp[5]); w.w = pk2(f[6] * r * gp[6], f[7] * r * gp[7]);
                    qf[ds] = __builtin_bit_cast(bf16x8, w); } }
            f32x16 sc[5];
            const LAS unsigned char* kbase = lds + (32 * rb + r32) * 128;
            int kch[4];
#pragma unroll
            for (int ds = 0; ds < 4; ++ds) kch[ds] = ((2 * ds + hi) ^ (r32 & 7)) * 16;
#pragma unroll
            for (int tt = 0; tt < 5; ++tt) {
#pragma unroll
                for (int r = 0; r < 16; ++r) sc[tt][r] = 0.f;
#pragma unroll
                for (int ds = 0; ds < 4; ++ds) { const bf16x8 kf = *(const LAS bf16x8*)(kbase + kch[ds] + tt * 4096);
                    sc[tt] = __builtin_amdgcn_mfma_f32_32x32x16_bf16(kf, qf[ds], sc[tt], 0, 0, 0); } }
            float mx = -INFINITY;
            int lq = r32 - 4 * hi, lf = 32 * rb + 4 * hi; asm volatile("" : "+v"(lq), "+v"(lf));
            const float lbase = slope2 * (float)(128 + lq);
#pragma unroll
            for (int tt = 0; tt < 5; ++tt)
#pragma unroll
                for (int r = 0; r < 16; ++r) { const int c0 = (r & 3) + 8 * (r >> 2), cc = 32 * tt + c0;
                    float v = fmaf(slope2, (float)cc, sc[tt][r] - lbase);
                    bool ok = true; if (tt == 0) ok = c0 > lq; if (tt == 4) ok = c0 <= lq;
                    if (first && (lf < 128 - cc)) ok = false;
                    v = ok ? v : -INFINITY; sc[tt][r] = v; mx = fmaxf(mx, v); }
            mx = fmaxf(xmax32(mx), sink2);
            float ls = 0.f;
#pragma unroll
            for (int tt = 0; tt < 5; ++tt)
#pragma unroll
                for (int r = 0; r < 16; ++r) { const float p = __builtin_amdgcn_exp2f(sc[tt][r] - mx); sc[tt][r] = p; ls += p; }
            ls = xsum32(ls) + __builtin_amdgcn_exp2f(sink2 - mx);
            const float inv = 1.f / ls;
            f32x16 o[2];
#pragma unroll
            for (int db = 0; db < 2; ++db)
#pragma unroll
                for (int r = 0; r < 16; ++r) o[db][r] = 0.f;
            const int g4 = lane >> 4, i16 = lane & 15;
            const LAS unsigned char* vbase = lds + 32768 + (32 * rb + 4 * (g4 >> 1) + (i16 >> 2)) * 128 + (16 * (g4 & 1) + 4 * (i16 & 3)) * 2;
#pragma unroll
            for (int tt = 0; tt < 5; ++tt)
#pragma unroll
                for (int s2 = 0; s2 < 2; ++s2) {
                    u32x4 pw; pw.x = cvt_pk_bf16(sc[tt][8 * s2 + 0], sc[tt][8 * s2 + 1]); pw.y = cvt_pk_bf16(sc[tt][8 * s2 + 2], sc[tt][8 * s2 + 3]);
                    pw.z = cvt_pk_bf16(sc[tt][8 * s2 + 4], sc[tt][8 * s2 + 5]); pw.w = cvt_pk_bf16(sc[tt][8 * s2 + 6], sc[tt][8 * s2 + 7]);
                    const bf16x8 pb = __builtin_bit_cast(bf16x8, pw);
#pragma unroll
                    for (int db = 0; db < 2; ++db) {
                        const s16x4 lo = __builtin_bit_cast(s16x4, __builtin_amdgcn_ds_read_tr16_b64_v4i16((LAS s16x4*)(vbase + tt * 4096 + s2 * 2048 + db * 64)));
                        const s16x4 hi4 = __builtin_bit_cast(s16x4, __builtin_amdgcn_ds_read_tr16_b64_v4i16((LAS s16x4*)(vbase + tt * 4096 + s2 * 2048 + 1024 + db * 64)));
                        const bf16x8 vf = (bf16x8){lo[0], lo[1], lo[2], lo[3], hi4[0], hi4[1], hi4[2], hi4[3]};
                        o[db] = __builtin_amdgcn_mfma_f32_32x32x16_bf16(vf, pb, o[db], 0, 0, 0); } }
            bf16_t* orow = attn + (size_t)tq * QD + h * 64 + 4 * hi;
#pragma unroll
            for (int db = 0; db < 2; ++db)
#pragma unroll
                for (int gq = 0; gq < 4; ++gq) { u32x2 w; w.x = cvt_pk_bf16(o[db][4 * gq + 0] * inv, o[db][4 * gq + 1] * inv); w.y = cvt_pk_bf16(o[db][4 * gq + 2] * inv, o[db][4 * gq + 3] * inv);
                    *(u32x2*)(orow + 32 * db + 8 * gq) = w; }
        }
        __syncthreads();
    }
#undef ATT_LOAD
}

__global__ void __launch_bounds__(NT, 2) mk_fwd(P a) {
    cg::grid_group grid = cg::this_grid();
    extern __shared__ __attribute__((aligned(16))) unsigned char lds[];
    LAS unsigned char* lds3 = (LAS unsigned char*)lds;
    const int wave_s = __builtin_amdgcn_readfirstlane((int)threadIdx.x >> 6);
    int tid, half, vt, tx, ty, lane, wave; float (*As)[68]; float (*Bs)[64]; size_t gtid;
#define REFRESH() do { tid = wave_s * 64 + lane_id(); asm volatile("" : "+v"(tid)); half = tid >> 8; vt = tid & 255; tx = vt & 15; ty = vt >> 4; lane = tid & 63; wave = tid >> 6; \
        As = (float (*)[68])(lds + half * 8704); Bs = (float (*)[64])(lds + half * 8704 + 4352); gtid = (size_t)blockIdx.x * NT + tid; } while (0)
    REFRESH();
    if (tid < 2) ((volatile LAS unsigned*)(lds3 + LDS_TAB + 1024))[tid] = 0u;
    __syncthreads();
    const XcdBarrier xbar = xcd_barrier_post((unsigned*)(a.ws + C_BAR), (volatile LAS unsigned*)(lds3 + LDS_TAB + 1024), wave_s == 0);
    const int G = gridDim.x; const size_t gthreads = (size_t)G * NT; const int nwaves = G * (NT / 64);
#define Wcat ((bf16_t*)(a.ws + W_CAT))
#define Wpp ((bf16_t*)(a.ws + W_PP))
#define Wmix ((bf16_t*)(a.ws + W_MIX))
#define Wa_ ((bf16_t*)(a.ws + W_A))
#define Wb_ ((bf16_t*)(a.ws + W_B))
#define Wout ((bf16_t*)(a.ws + W_OUT))
#define Wsh ((bf16_t*)(a.ws + W_SH))
#define Wr ((bf16_t*)(a.ws + W_R))
#define Wsd ((bf16_t*)(a.ws + W_SD))
#define Wpg ((bf16_t*)(a.ws + W_PG))
#define Wexp ((bf16_t*)(a.ws + W_EXP))
#define Wed ((bf16_t*)(a.ws + W_ED))
#define rsspp ((float*)(a.ws + C_RSPP))
#define rss2 ((float*)(a.ws + C_RS2))
#define rss3 ((float*)(a.ws + C_RS3))
#define cntblk ((int*)(a.ws + C_CNTBLK))
#define sel ((int*)(a.ws + C_SEL))
#define tokl ((int*)(a.ws + C_TOKL))
#define rinfo ((int2*)(a.ws + C_RINFO))
#define wl ((float*)(a.ws + LOGITS))
#define Yb ((unsigned char*)(a.ws + YB))
#define wts ((float*)(a.ws + C_WTS))
#define ppb ((bf16_t*)(a.ws + PP))
#define hb ((bf16_t*)(a.ws + HB))
#define pb ((bf16_t*)(a.ws + PB))
#define ub ((bf16_t*)(a.ws + UB))
#define gb ((bf16_t*)(a.ws + GB))
#define poolb ((bf16_t*)(a.ws + POOLB))
#define logits ((float*)(a.ws + LOGITS))
#define attnb ((bf16_t*)(a.ws + HB))
#define mixb ((bf16_t*)(a.ws + HB + 32 * MiB))
#define mergedb ((bf16_t*)(a.ws + UB))
#define hg2 ((bf16_t*)(out))
#define hg3 ((bf16_t*)(a.ws + W_EXP))
#define actsh ((bf16_t*)(a.ws + ACTSH))
#define actr ((bf16_t*)(a.ws + ACTR))
#define out (a.out)
    {
        LAS float* scr = (LAS float*)(lds3 + wave * 16384);
        const int gw = blockIdx.x * (NT / 64) + wave;
        constexpr int I_IN = 16 * 40, I_G = 16 * 64, I_PP = 4 * 32, I_AB = 8 * 32, I_SQ = 16 * 32, I_GU = 16 * 8, I_R = 16 * 2, I_SD = 4 * 32;
        constexpr int I_E = NE * 128;
        constexpr int NITEMS = I_IN + I_G + I_PP + 2 * I_AB + 2 * I_SQ + 2 * I_GU + I_R + I_SD + 3 * I_E;
        auto decode = [&](int it) -> TItem { int r = it;
            if (r < I_IN) return ti_plain(a.w_in, D, IND, Wcat, 0, r); r -= I_IN;
            if (r < I_G) return ti_gate(a.w_gate, Wcat, r); r -= I_G;
            if (r < I_PP) return ti_plain(a.w_pp, PLE, D, Wpp, 0, r); r -= I_PP;
            if (r < I_AB) return ti_plain(a.w_a, 512, D, Wa_, 0, r); r -= I_AB;
            if (r < I_AB) return ti_plain(a.w_b, 512, D, Wb_, 0, r); r -= I_AB;
            if (r < I_SQ) return ti_plain(a.w_out, D, D, Wout, 0, r); r -= I_SQ;
            if (r < I_SQ) return ti_plain(a.w_pg, D, D, Wpg, 0, r, a.g_ple); r -= I_SQ;
            if (r < I_GU) return ti_gu(a.w_sg, Wsh, 0, r, a.g_ffn); r -= I_GU;
            if (r < I_GU) return ti_gu(a.w_su, Wsh, 1, r, a.g_ffn); r -= I_GU;
            if (r < I_R) return ti_plain(a.w_router, D, NE, Wr, 0, r, a.g_ffn); r -= I_R;
            if (r < I_SD) return ti_plain(a.w_sd, SD, D, Wsd, 0, r); r -= I_SD;
            if (r < I_E) { const int e = r >> 7; return ti_gu(a.w_eg + (size_t)e * D * ED, Wexp + (size_t)e * 512 * D, 0, r & 127, a.g_ffn); } r -= I_E;
            if (r < I_E) { const int e = r >> 7; return ti_gu(a.w_eu + (size_t)e * D * ED, Wexp + (size_t)e * 512 * D, 1, r & 127, a.g_ffn); } r -= I_E;
            { const int e = r >> 7; return ti_plain(a.w_ed + (size_t)e * ED * D, ED, D, Wed + (size_t)e * D * ED, 0, r & 127); } };
        if (gw < NITEMS) {
            TItem cur_ = decode(gw); f32x4 va[8], vb[8]; ti_load(cur_, va, lane);
            for (int it = gw; it < NITEMS; it += 2 * nwaves) {
                const int i1 = it + nwaves, i2 = it + 2 * nwaves; TItem n1 = cur_, n2 = cur_;
                if (i1 < NITEMS) { n1 = decode(i1); ti_load(n1, vb, lane); }
                ti_finish(cur_, va, scr, lane);
                if (i1 < NITEMS) { if (i2 < NITEMS) { n2 = decode(i2); ti_load(n2, va, lane); } ti_finish(n1, vb, scr, lane); cur_ = n2; }
            }
        }
        for (size_t i = gtid; i < (size_t)2 * 256 * 256; i += gthreads) { const int pn = (int)(i >> 16), n = (int)((i >> 8) & 255), k = (int)(i & 255);
            const float v = ((n >> 7) == (k >> 7)) ? a.w_pool_mix[(size_t)(2 * pn + (n >> 7)) * 128 * 128 + (size_t)(k & 127) * 128 + (n & 127)] * a.pool_scale[256 * pn + n] : 0.f;
            Wmix[i] = (bf16_t)f2bf(v); }
        for (size_t i = gtid; i < (size_t)192 * D / 8; i += gthreads) *((u32x4*)(Wr + (size_t)64 * D) + i) = (u32x4){0u, 0u, 0u, 0u};
        for (int m0 = gw; m0 < T; m0 += 2 * nwaves) {
            f32x4 v[2][4], pv[2]; float sq[2];
#pragma unroll
            for (int rr = 0; rr < 2; ++rr) { const int m = (m0 + rr * nwaves < T) ? m0 + rr * nwaves : m0; const f32x4* xr = (const f32x4*)(a.x + (size_t)m * D) + lane;
#pragma unroll
                for (int j = 0; j < 4; ++j) v[rr][j] = xr[64 * j];
                pv[rr] = *((const f32x4*)(a.p + (size_t)m * PLE) + lane); }
#pragma unroll
            for (int rr = 0; rr < 2; ++rr) { float s_ = 0.f;
#pragma unroll
                for (int j = 0; j < 4; ++j) s_ += (v[rr][j].x * v[rr][j].x + v[rr][j].y * v[rr][j].y) + (v[rr][j].z * v[rr][j].z + v[rr][j].w * v[rr][j].w);
                sq[rr] = wave_sum(s_); }
#pragma unroll
            for (int rr = 0; rr < 2; ++rr) { const int m = m0 + rr * nwaves; if (m < T) { const float r = rsqrtf(sq[rr] * (1.f / D) + EPS);
                u32x2* o8 = (u32x2*)(hb + (size_t)m * D) + lane;
#pragma unroll
                for (int j = 0; j < 4; ++j) { const f32x4 gg = *((const f32x4*)a.g_mix + lane + 64 * j); u32x2 w; w.x = pk2(v[rr][j].x * r * gg.x, v[rr][j].y * r * gg.y); w.y = pk2(v[rr][j].z * r * gg.z, v[rr][j].w * r * gg.w); o8[64 * j] = w; }
                u32x2 w; w.x = pk2(pv[rr].x, pv[rr].y); w.y = pk2(pv[rr].z, pv[rr].w); *((u32x2*)(pb + (size_t)m * PLE) + lane) = w; } }
        }
        for (size_t i = gtid; i < (size_t)T; i += gthreads) { rsspp[i] = 0.f; rss2[i] = 0.f; rss3[i] = 0.f; }
    }
    if (gridDim.x == 0x7fffffffu) grid.sync();
    xcd_barrier(xbar, tid); REFRESH();
    {
        pg8::Cfg g1{(unsigned)D * 2u, (unsigned)D * 2u, D};
        pg8::DenseSched S1{T / 256, NCAT / 256, G, (int)blockIdx.x, (const char*)hb, (const char*)Wcat, (size_t)256 * D * 2, (size_t)256 * D * 2};
        EpiG1 E1{ub, gb, a.b_gate};
        pg8::gemm_phase<EpiG1, pg8::DenseSched, false>(lds3, g1, S1, E1, wave_s);
        pg8::Cfg g2{(unsigned)PLE * 2u, (unsigned)PLE * 2u, PLE};
        PPSched S2{G, (int)blockIdx.x, (const char*)pb, (const char*)Wpp};
        EpiPP E2{ppb, rsspp};
        pg8::gemm_phase<EpiPP, PPSched, false>(lds3, g2, S2, E2, wave_s);
    }
    xcd_barrier(xbar, tid); REFRESH();
    for (int i = 0;; ++i) { int pm, pn; if (!pg8::static_tile(i, G, (int)blockIdx.x, T / 256, 2, pm, pn)) break;
        const int ch = tid & 31, rg = tid >> 5, col = 256 * pn + 8 * ch, w = 2 << (col >> 7), t0 = 256 * pm + 16 * rg, pos0 = t0 % SEQ;
        const bf16_t* rp0 = ub + (size_t)t0 * IND + col; float sw[8];
#pragma unroll
        for (int q = 0; q < 8; ++q) sw[q] = 0.f;
        { u32x4 pv[15];
#pragma unroll
          for (int k = 1; k < 16; ++k) pv[k - 1] = *(const u32x4*)(rp0 - (size_t)((k < w && k <= pos0) ? k : 0) * IND);
#pragma unroll
          for (int k = 1; k < 16; ++k) { const float mk = (k < w && k <= pos0) ? 1.f : 0.f; const u32x4 p4 = pv[k - 1];
              sw[0] += mk * bf2f(p4.x & 0xffffu); sw[1] += mk * bf2f(p4.x >> 16); sw[2] += mk * bf2f(p4.y & 0xffffu); sw[3] += mk * bf2f(p4.y >> 16);
              sw[4] += mk * bf2f(p4.z & 0xffffu); sw[5] += mk * bf2f(p4.z >> 16); sw[6] += mk * bf2f(p4.w & 0xffffu); sw[7] += mk * bf2f(p4.w >> 16); } }
#pragma unroll 1
        for (int b4 = 0; b4 < 4; ++b4) { u32x4 nw[4], od[4];
#pragma unroll
            for (int j = 0; j < 4; ++j) { const int r = 4 * b4 + j; nw[j] = *(const u32x4*)(rp0 + (size_t)r * IND);
                od[j] = *(const u32x4*)(rp0 + (size_t)((pos0 + r >= w - 1) ? r - (w - 1) : r) * IND); }
#pragma unroll
            for (int j = 0; j < 4; ++j) { const int r = 4 * b4 + j; const int cn = pos0 + r + 1 < w ? pos0 + r + 1 : w; const float ic = 1.f / (float)cn, mo = (pos0 + r >= w - 1) ? 1.f : 0.f;
                const float c8[8] = {bf2f(nw[j].x & 0xffffu), bf2f(nw[j].x >> 16), bf2f(nw[j].y & 0xffffu), bf2f(nw[j].y >> 16), bf2f(nw[j].z & 0xffffu), bf2f(nw[j].z >> 16), bf2f(nw[j].w & 0xffffu), bf2f(nw[j].w >> 16)};
                const float o8[8] = {bf2f(od[j].x & 0xffffu), bf2f(od[j].x >> 16), bf2f(od[j].y & 0xffffu), bf2f(od[j].y >> 16), bf2f(od[j].z & 0xffffu), bf2f(od[j].z >> 16), bf2f(od[j].w & 0xffffu), bf2f(od[j].w >> 16)};
                float e8[8];
#pragma unroll
                for (int q = 0; q < 8; ++q) { sw[q] += c8[q]; e8[q] = sw[q] * ic - c8[q]; sw[q] -= mo * o8[q]; }
                u32x4 o; o.x = pk2(e8[0], e8[1]); o.y = pk2(e8[2], e8[3]); o.z = pk2(e8[4], e8[5]); o.w = pk2(e8[6], e8[7]);
                *(u32x4*)(poolb + (size_t)(t0 + r) * POOLD + col) = o; } } }
    asm volatile("s_waitcnt vmcnt(0)" ::: "memory");
    __syncthreads();
    {
        pg8::Cfg gm{(unsigned)POOLD * 2u, 512u, 256};
        MixSched Sm{G, (int)blockIdx.x, (const char*)poolb, (const char*)Wmix};
        EpiBf16Plain Em{mixb, POOLD};
        pg8::gemm_phase<EpiBf16Plain, MixSched, false>(lds3, gm, Sm, Em, wave_s);
    }
    REFRESH();
    attn_phase(lds3, ub, attnb, a.sinks, a.q_gain, a.k_gain, G, wave_s);
    xcd_barrier(xbar, tid); REFRESH();
    {
        pg8::Cfg g4{1024u, 1024u, 512};
        MergedSched S4{G, (int)blockIdx.x, (const char*)mixb, (const char*)attnb, (const char*)Wa_, (const char*)Wb_};
        EpiMerged E4{gb, mergedb};
        pg8::gemm_phase<EpiMerged, MergedSched, false>(lds3, g4, S4, E4, wave_s);
    }
    xcd_barrier(xbar, tid); REFRESH();
    {
        pg8::Cfg g5{(unsigned)D * 2u, (unsigned)D * 2u, D};
        pg8::DenseSched S5{T / 256, D / 256, G, (int)blockIdx.x, (const char*)mergedb, (const char*)Wout, (size_t)256 * D * 2, (size_t)256 * D * 2};
        EpiResid E5{a.x, hg2, rss2};
        pg8::gemm_phase<EpiResid, pg8::DenseSched, false>(lds3, g5, S5, E5, wave_s);
    }
    xcd_barrier(xbar, tid); REFRESH();
    {
        pg8::Cfg g6{(unsigned)D * 2u, (unsigned)D * 2u, D};
        P6Sched S6{G, (int)blockIdx.x, (const char*)hg2, (const char*)Wsh};
        EpiShared E6{actsh, logits, rss2};
        pg8::gemm_phase<EpiShared, P6Sched, false>(lds3, g6, S6, E6, wave_s);
    }
    REFRESH();
    if (G != 256) { xcd_barrier(xbar, tid); REFRESH(); }
    __syncthreads();
    for (int cpair = blockIdx.x; cpair < NCHUNK / 2; cpair += G) {
        float (*C)[65] = (float (*)[65])(lds + (wave & 3) * 16640);
        int* cw = (int*)(lds + 4 * 16640);
        const int ch = cpair * 2 + ((wave >> 1) & 1);
        int idx[8], rk[8]; float sv[8]; const int t = ch * 128 + (wave & 1) * 64 + lane;
        if (wave < 4) {
            { const f32x4* lg4 = (const f32x4*)(logits + (size_t)(t - lane) * 64); const f32x4 b4 = *((const f32x4*)a.router_bias + (lane & 15)); f32x4 lv[16];
#pragma unroll
              for (int i = 0; i < 16; ++i) lv[i] = lg4[i * 64 + lane];
#pragma unroll
              for (int i = 0; i < 16; ++i) { float* cr = &C[4 * i + (lane >> 4)][4 * (lane & 15)];
#pragma unroll
                  for (int q = 0; q < 4; ++q) cr[q] = 1.f / (1.f + expf(-lv[i][q])) + b4[q]; } }
            float gs[8];
#pragma unroll
            for (int g = 0; g < 8; ++g) { float m1 = -INFINITY, m2 = -INFINITY;
#pragma unroll
                for (int j = 0; j < 8; ++j) { const float v = C[lane][g * 8 + j]; if (v > m1) { m2 = m1; m1 = v; } else if (v > m2) m2 = v; }
                gs[g] = m1 + m2; }
            unsigned gsel = 0u;
#pragma unroll
            for (int it = 0; it < 4; ++it) { float best = -INFINITY; int bi = 0;
#pragma unroll
                for (int g = 0; g < 8; ++g) { const bool fr_ = !((gsel >> g) & 1u); if (fr_ && gs[g] > best) { best = gs[g]; bi = g; } }
                gsel |= 1u << bi; }
            unsigned long long chosen = 0ull; float wsum = 0.f;
#pragma unroll
            for (int g = 0; g < 8; ++g) if (!((gsel >> g) & 1u)) {
#pragma unroll
                for (int j = 0; j < 8; ++j) C[lane][g * 8 + j] = -INFINITY; }
#pragma unroll
            for (int k = 0; k < 8; ++k) { float best = -INFINITY; int bi = 0;
#pragma unroll 8
                for (int e = 0; e < 64; ++e) { const float v = C[lane][e]; if (v > best) { best = v; bi = e; } }
                C[lane][bi] = -INFINITY; chosen |= 1ull << bi; idx[k] = bi; sv[k] = 1.f / (1.f + expf(-logits[(size_t)t * 64 + bi])); wsum += sv[k]; rk[k] = 0; }
#pragma unroll
            for (int k = 0; k < 8; ++k) sv[k] = sv[k] / (wsum + 1e-20f) * 2.5f;
#pragma unroll 1
            for (int e = 0; e < 64; ++e) { const bool chs = (chosen >> e) & 1ull; const unsigned long long mm = __ballot(chs); const int r = __popcll(mm & ((1ull << lane) - 1ull));
                if (lane == 0) cw[wave * 64 + e] = __popcll(mm);
#pragma unroll
                for (int k = 0; k < 8; ++k) if (idx[k] == e) rk[k] = r; }
        }
        __syncthreads();
        if (wave < 4) {
#pragma unroll
            for (int k = 0; k < 8; ++k) { const int r = rk[k] + ((wave & 1) ? cw[(wave - 1) * 64 + idx[k]] : 0); sel[(size_t)t * 8 + k] = idx[k] | (r << 8); wts[(size_t)t * 8 + k] = sv[k]; }
            if ((wave & 1) == 0) cntblk[ch * 64 + lane] = cw[wave * 64 + lane] + cw[(wave + 1) * 64 + lane];
        }
        __syncthreads();
    }
    xcd_barrier(xbar, tid); REFRESH();
    {
        int* tot = (int*)(lds + 0); int* pst = (int*)(lds + 512); int* base = (int*)(lds + 1024); LAS int* mts = (LAS int*)(lds3 + LDS_TAB);
        int* part = (int*)(lds + 2048);
        LAS int* lo_t = (LAS int*)(lds3 + LDS_TAB + LT_LO); LAS int* tst_t = (LAS int*)(lds3 + LDS_TAB + LT_TST);
        LAS unsigned char* t2e7 = lds3 + LDS_TAB + LT_T2E7; LAS unsigned char* t2e8 = lds3 + LDS_TAB + LT_T2E8;
        const int e_ = tid & 63, pt = tid >> 6; const int ch0 = blockIdx.x;
        { int sr[NROUND + 1];
#pragma unroll
          for (int r = 0; r <= NROUND; ++r) sr[r] = 0;
#pragma unroll 4
          for (int c2 = pt; c2 < NCHUNK; c2 += 8) { const int v = cntblk[c2 * 64 + e_]; sr[0] += v; sr[NROUND] += (c2 < ch0) ? v : 0;
#pragma unroll
              for (int r = 1; r < NROUND; ++r) sr[r] += (c2 < r * (NCHUNK / NROUND)) ? v : 0; }
#pragma unroll
          for (int r = 0; r <= NROUND; ++r) part[r * 512 + pt * 64 + e_] = sr[r]; }
        __syncthreads();
        if (tid < 64) {
#pragma unroll
            for (int r = 0; r <= NROUND; ++r) { int sm = 0;
#pragma unroll
                for (int q = 0; q < 8; ++q) sm += part[r * 512 + q * 64 + tid];
                if (r == 0) tot[tid] = sm; else if (r == NROUND) base[tid] = sm; else lo_t[r * 64 + tid] = sm; } }
        __syncthreads();
        if (tid == 0) { int p = 0, m = 0; for (int e = 0; e < 64; ++e) { pst[e] = p; mts[e] = m; const int pd = (tot[e] + 255) & ~255; p += pd; m += pd >> 8; } pst[64] = p; mts[64] = m; mts[65] = m; }
        __syncthreads();
        if (tid < 64) { const int p0 = pst[tid]; lo_t[tid] = p0;
#pragma unroll
            for (int r = 1; r < NROUND; ++r) lo_t[r * 64 + tid] += p0;
            lo_t[NROUND * 64 + tid] = p0 + tot[tid];
            for (int j = mts[tid]; j < mts[tid + 1]; ++j) t2e7[j] = (unsigned char)tid; }
        __syncthreads();
        if (tid < NROUND) { LAS int* cb_t = (LAS int*)(lds3 + LDS_TAB + LT_CB); int m = 0, cacc = 0; for (int e = 0; e < 64; ++e) { tst_t[tid * 65 + e] = m; cb_t[tid * 64 + e] = cacc; cacc += lo_t[(tid + 1) * 64 + e] - lo_t[tid * 64 + e]; const int nt_ = (lo_t[(tid + 1) * 64 + e] - lo_t[tid * 64 + e] + 255) >> 8;
                for (int j = 0; j < nt_; ++j) t2e8[tid * T2S + (m + j)] = (unsigned char)e; m += nt_; } tst_t[tid * 65 + 64] = m; }
        __syncthreads();
        if ((int)blockIdx.x < 64 && tid < 256) { const int e = blockIdx.x; const int j = tot[e] + tid; if (j < ((tot[e] + 255) & ~255)) { tokl[pst[e] + j] = -1; rinfo[pst[e] + j] = make_int2(-1, 0); wl[pst[e] + j] = 0.f; } }
        for (int ch = blockIdx.x; ch < NCHUNK; ch += G) {
            if (ch != ch0) {
                __syncthreads();
                if (tid < 64) { int sum = 0;
#pragma unroll 4
                    for (int c2 = 0; c2 < ch; ++c2) sum += cntblk[c2 * 64 + tid];
                    base[tid] = sum; }
                __syncthreads();
            }
            if (tid < 128) { const int t = ch * 128 + tid;
#pragma unroll
                for (int k = 0; k < 8; ++k) { const int sl = sel[(size_t)t * 8 + k]; const int e_k = sl & 255, pos = pst[e_k] + base[e_k] + (sl >> 8), rr_ = t / TR;
                    sel[(size_t)t * 8 + k] = ((const LAS int*)(lds3 + LDS_TAB + LT_CB))[rr_ * 64 + e_k] + (pos - lo_t[rr_ * 64 + e_k]);
                    tokl[pos] = t * 8 + k; rinfo[pos] = make_int2(t * 9 + k, __float_as_int(rsqrtf(rss2[t] * (1.f / D) + EPS))); wl[pos] = wts[(size_t)t * 8 + k]; } }
        }
    }
    xcd_barrier(xbar, tid); REFRESH();
    const int ntr = ((LAS int*)(lds3 + LDS_TAB))[64];
    {
        pg8::Cfg g7{(unsigned)D * 2u, (unsigned)D * 2u, D};
        RoutedUpSched S7{G, (int)blockIdx.x, ntr, (const LAS unsigned char*)(lds3 + LDS_TAB + LT_T2E7), tokl, (const char*)hg2, (const char*)Wexp};
        EpiRoutedUp E7{actr, rinfo, wl};
        pg8::gemm_phase<EpiRoutedUp, RoutedUpSched, true>(lds3, g7, S7, E7, wave_s);
    }
    xcd_barrier(xbar, tid); REFRESH();
#pragma unroll 1
    for (int q = 0; q <= NROUND; ++q) {
#pragma unroll 1
        for (int part2 = 0; part2 < 2; ++part2) {
            const bool do_down = (part2 == (int)(blockIdx.x & 1));
            if (do_down) { if (q < NROUND) {
                pg8::Cfg g8{(unsigned)ED * 2u, (unsigned)ED * 2u, ED};
                DownSched S8{G, (int)blockIdx.x, q, (const LAS int*)(lds3 + LDS_TAB + LT_LO), (const LAS int*)(lds3 + LDS_TAB + LT_TST), (const LAS unsigned char*)(lds3 + LDS_TAB + LT_T2E8), (const LAS int*)(lds3 + LDS_TAB + LT_CB), (const char*)actr, (const char*)actsh, (const char*)Wed, (const char*)Wsd};
                EpiDown E8{Yb + (size_t)(q & 1) * TR * 9 * 1024};
                pg8::gemm_phase<EpiDown, DownSched, false>(lds3, g8, S8, E8, wave_s);
                REFRESH(); }
            } else if (q > 0) { const int qc = q - 1;
                char* wsl = a.ws; float* outl = out; asm volatile("" : "+s"(wsl), "+s"(outl));
                const unsigned char* Yc = (const unsigned char*)(wsl + YB) + (size_t)(qc & 1) * TR * 9 * 1024; const int* sel_l = (const int*)(wsl + C_SEL); const bf16_t* x1l = (const bf16_t*)outl; bf16_t* x2l = (bf16_t*)(wsl + W_EXP); float* rss3l = (float*)(wsl + C_RS3);
                int rem = 0; if (q < NROUND) rem = ((((const LAS int*)(lds3 + LDS_TAB + LT_TST))[q * 65 + 64] + TR / 256) * 4) % G;
                if (rem > G / 2) rem = 0;
                const int li = (int)blockIdx.x - rem, nlw = (G - rem) * (NT / 64);
                if (li >= 0)
                for (int tl0 = li * (NT / 64) + wave; tl0 < TR; tl0 += 2 * nlw) { const int nwaves_c = nlw; const int col = lane * 16;
                    u32x4 y[2][9], xa[2], xb_[2];
#pragma unroll
                    for (int u2 = 0; u2 < 2; ++u2) { const int tl_ = (tl0 + u2 * nwaves_c < TR) ? tl0 + u2 * nwaves_c : tl0; const int t = qc * TR + tl_;
                        const bf16_t* xi = x1l + (size_t)t * D + col;
#pragma unroll
                        for (int k = 0; k < 8; ++k) y[u2][k] = *(const u32x4*)(Yc + (size_t)sel_l[(size_t)t * 8 + k] * 1024 + col);
                        y[u2][8] = *(const u32x4*)(Yc + (size_t)(8 * TR + tl_) * 1024 + col);
                        xa[u2] = *(const u32x4*)xi; xb_[u2] = *(const u32x4*)(xi + 8); }
#pragma unroll
                    for (int u2 = 0; u2 < 2; ++u2) { const int tl_ = tl0 + u2 * nwaves_c; if (tl_ < TR) { const int t = qc * TR + tl_;
                        f32x4 v[4];
                        v[0] = (f32x4){bf2f(xa[u2].x & 0xffffu), bf2f(xa[u2].x >> 16), bf2f(xa[u2].y & 0xffffu), bf2f(xa[u2].y >> 16)}; v[1] = (f32x4){bf2f(xa[u2].z & 0xffffu), bf2f(xa[u2].z >> 16), bf2f(xa[u2].w & 0xffffu), bf2f(xa[u2].w >> 16)};
                        v[2] = (f32x4){bf2f(xb_[u2].x & 0xffffu), bf2f(xb_[u2].x >> 16), bf2f(xb_[u2].y & 0xffffu), bf2f(xb_[u2].y >> 16)}; v[3] = (f32x4){bf2f(xb_[u2].z & 0xffffu), bf2f(xb_[u2].z >> 16), bf2f(xb_[u2].w & 0xffffu), bf2f(xb_[u2].w >> 16)};
#pragma unroll
                        for (int k = 0; k < 9; ++k)
#pragma unroll
                            for (int j = 0; j < 4; ++j) { const f32x2 lo2 = __builtin_amdgcn_cvt_pk_f32_fp8((int)y[u2][k][j], false), hi2 = __builtin_amdgcn_cvt_pk_f32_fp8((int)y[u2][k][j], true);
                                v[j][0] += lo2.x; v[j][1] += lo2.y; v[j][2] += hi2.x; v[j][3] += hi2.y; }
                        float ss = 0.f; u32x4 w0, w1;
#pragma unroll
                        for (int j = 0; j < 4; ++j) { const unsigned p0 = pk2(v[j][0], v[j][1]), p1 = pk2(v[j][2], v[j][3]);
                            if (j == 0) { w0.x = p0; w0.y = p1; } else if (j == 1) { w0.z = p0; w0.w = p1; } else if (j == 2) { w1.x = p0; w1.y = p1; } else { w1.z = p0; w1.w = p1; }
                            ss += (v[j][0] * v[j][0] + v[j][1] * v[j][1]) + (v[j][2] * v[j][2] + v[j][3] * v[j][3]); }
                        *(u32x4*)(x2l + (size_t)t * D + col) = w0; *(u32x4*)(x2l + (size_t)t * D + col + 8) = w1;
                        ss = wave_sum(ss);
                        if (lane == 0) rss3l[t] = ss; } }
                }
            }
        }
        xcd_barrier(xbar, tid); REFRESH();
    }
    {
        pg8::Cfg g9{(unsigned)D * 2u, (unsigned)D * 2u, D};
        pg8::DenseSched S9{T / 256, D / 256, G, (int)blockIdx.x, (const char*)hg3, (const char*)Wpg, (size_t)256 * D * 2, (size_t)256 * D * 2};
        EpiFinal E9{out, hg3, ppb, rss3, rsspp, a.g_post};
        pg8::gemm_phase<EpiFinal, pg8::DenseSched, false>(lds3, g9, S9, E9, wave_s);
    }
}
#undef Wcat
#undef Wpp
#undef Wmix
#undef Wa_
#undef Wb_
#undef Wout
#undef Wsh
#undef Wr
#undef Wsd
#undef Wpg
#undef Wexp
#undef Wed
#undef rsspp
#undef rss2
#undef rss3
#undef cntblk
#undef sel
#undef tokl
#undef rinfo
#undef wl
#undef Yb
#undef wts
#undef ppb
#undef hb
#undef pb
#undef ub
#undef gb
#undef poolb
#undef logits
#undef attnb
#undef mixb
#undef mergedb
#undef hg2
#undef hg3
#undef actsh
#undef actr
#undef out
}

extern "C" void kernel_launch(void* const* d_in, const int* in_sizes, int n_in, void* d_out, int out_size, void* d_ws, size_t ws_size, hipStream_t stream) {
    using namespace mk;
    static int grid_blocks = 0;
    constexpr size_t LDSB = 147456;
    if (!grid_blocks) {
        int dev = 0, cus = 0, per_cu = 0;
        (void)hipGetDevice(&dev); (void)hipDeviceGetAttribute(&cus, hipDeviceAttributeMultiprocessorCount, dev);
        (void)hipFuncSetAttribute((const void*)mk_fwd, hipFuncAttributeMaxDynamicSharedMemorySize, (int)LDSB);
        (void)hipOccupancyMaxActiveBlocksPerMultiprocessor(&per_cu, (const void*)mk_fwd, NT, LDSB);
        if (per_cu < 1) { fprintf(stderr, "occupancy query says %d blocks per CU\n", per_cu); }
        grid_blocks = cus;
    }
    if (ws_size < (size_t)512 * MiB) { fprintf(stderr, "ws too small: %zu\n", ws_size); return; }
    P a{};
    a.x = (const float*)d_in[0]; a.p = (const float*)d_in[1]; a.g_mix = (const float*)d_in[2]; a.w_in = (const float*)d_in[3]; a.w_pool_mix = (const float*)d_in[4];
    a.pool_scale = (const float*)d_in[5]; a.w_a = (const float*)d_in[6]; a.q_gain = (const float*)d_in[7]; a.k_gain = (const float*)d_in[8]; a.sinks = (const float*)d_in[9];
    a.w_b = (const float*)d_in[10]; a.w_gate = (const float*)d_in[11]; a.b_gate = (const float*)d_in[12]; a.w_out = (const float*)d_in[13]; a.g_ffn = (const float*)d_in[14];
    a.w_router = (const float*)d_in[15]; a.router_bias = (const float*)d_in[16]; a.w_eg = (const float*)d_in[17]; a.w_eu = (const float*)d_in[18]; a.w_ed = (const float*)d_in[19];
    a.w_sg = (const float*)d_in[20]; a.w_su = (const float*)d_in[21]; a.w_sd = (const float*)d_in[22]; a.g_ple = (const float*)d_in[23]; a.w_pg = (const float*)d_in[24];
    a.w_pp = (const float*)d_in[25]; a.g_post = (const float*)d_in[26]; a.out = (float*)d_out; a.ws = (char*)d_ws;
    (void)hipMemsetAsync((char*)d_ws + C_BAR, 0, 16384, stream);
    void* args[] = {&a};
    hipError_t e = hipLaunchCooperativeKernel((const void*)mk_fwd, dim3(grid_blocks), dim3(NT), args, LDSB, stream);
    if (e != hipSuccess) fprintf(stderr, "cooperative launch failed: %s (grid %d)\n", hipGetErrorString(e), grid_blocks);
}
```

```cpp
#include <hip/hip_runtime.h>
#include <hip/hip_cooperative_groups.h>
#include <cstdio>
#include <cstdint>
namespace cg = cooperative_groups;

#define LAS __attribute__((address_space(3)))
typedef unsigned short bf16_t;
typedef short bf16x8 __attribute__((ext_vector_type(8)));
typedef float f32x4 __attribute__((ext_vector_type(4)));
typedef unsigned u32x4 __attribute__((ext_vector_type(4)));
typedef unsigned u32x2 __attribute__((ext_vector_type(2)));
typedef float f32x2 __attribute__((ext_vector_type(2)));

namespace mk {
constexpr int T = 32768, D = 1024, SEQ = 4096, PLE = 256;
constexpr int POOLD = 512, QD = 512, KVD = 128, IND = 1280, NCAT = 3328;
constexpr int NE = 64, ED = 256, SD = 256;
constexpr float EPS = 1e-6f;
constexpr float LOG2E = 1.4426950408889634f;
constexpr int NT = 512;
constexpr size_t MiB = 1u << 20;
constexpr size_t W_CAT = 0;
constexpr size_t W_PP = W_CAT + (size_t)NCAT * D * 2;
constexpr size_t W_MIX = W_PP + (size_t)D * PLE * 2;
constexpr size_t W_A = W_MIX + 2 * 256 * 256 * 2;
constexpr size_t W_B = W_A + (size_t)D * 512 * 2;
constexpr size_t W_OUT = W_B + (size_t)D * 512 * 2;
constexpr size_t W_SH = W_OUT + (size_t)D * D * 2;
constexpr size_t W_R = W_SH + (size_t)512 * D * 2;
constexpr size_t W_SD = W_R + (size_t)256 * D * 2;
constexpr size_t W_PG = W_SD + (size_t)D * 256 * 2;
constexpr size_t W_EXP = 16 * MiB;
constexpr size_t W_ED = 80 * MiB;
static_assert(W_PG + (size_t)D * D * 2 <= W_EXP, "weights map");
constexpr size_t CTL = 112 * MiB;
constexpr size_t C_RSPP = CTL, C_RS2 = CTL + 128 * 1024, C_RS3 = CTL + 256 * 1024;
constexpr size_t C_CNTBLK = CTL + 512 * 1024;
constexpr size_t C_SEL = CTL + 2 * MiB;
constexpr size_t C_TOKL = CTL + 3 * MiB;
constexpr size_t C_RINFO = CTL + 4 * MiB + 512 * 1024;
constexpr size_t YB = 184 * MiB;
constexpr size_t ACTSH = 464 * MiB;
constexpr int NCHUNK = T / 128;
constexpr size_t C_BAR = CTL + 7 * MiB + 512 * 1024;
constexpr int NROUND = 4, TR = T / NROUND;
constexpr int LT_LO = 4096, LT_TST = LT_LO + (NROUND + 1) * 64 * 4, LT_T2E7 = LT_TST + NROUND * 65 * 4, LT_T2E8 = LT_T2E7 + 1152;
constexpr int T2S = TR * 8 / 256 + 64;
constexpr int LT_CB = LT_T2E8 + NROUND * T2S;
static_assert(LT_CB % 4 == 0 && LT_CB + NROUND * 64 * 4 <= 16384 && TR / 128 * NROUND == T / 128, "LDS tables");
constexpr int LDS_TAB = 131072;
constexpr size_t C_WTS = CTL + 1 * MiB;
constexpr size_t PP = 120 * MiB;
constexpr size_t HB = 184 * MiB;
constexpr size_t PB = 248 * MiB;
constexpr size_t UB = 264 * MiB;
constexpr size_t GB = 344 * MiB;
constexpr size_t POOLB = 472 * MiB;
constexpr size_t LOGITS = 504 * MiB;
constexpr size_t ACTR = 328 * MiB;

__device__ __forceinline__ int lane_id() { int l; asm volatile("v_mbcnt_lo_u32_b32 %0, -1, 0\n\tv_mbcnt_hi_u32_b32 %0, -1, %0" : "=v"(l)); return l; }
__device__ __forceinline__ float bf2f(unsigned v) { return __uint_as_float(v << 16); }
__device__ __forceinline__ unsigned f2bf(float f) { unsigned u = __float_as_uint(f); return (u + 0x7fffu + ((u >> 16) & 1u)) >> 16; }
__device__ __forceinline__ unsigned cvt_pk_bf16(float lo, float hi) { unsigned r; asm volatile("v_cvt_pk_bf16_f32 %0, %1, %2" : "=v"(r) : "v"(lo), "v"(hi)); return r; }
__device__ __forceinline__ unsigned pk2(float lo, float hi) { return f2bf(lo) | (f2bf(hi) << 16); }
__device__ __forceinline__ float dpp_f(float v, int ctrl_sel) {
    const int i = __float_as_int(v); int r;
    if (ctrl_sel == 0) r = __builtin_amdgcn_update_dpp(i, i, 0xB1, 0xF, 0xF, false);
    else if (ctrl_sel == 1) r = __builtin_amdgcn_update_dpp(i, i, 0x4E, 0xF, 0xF, false);
    else if (ctrl_sel == 2) r = __builtin_amdgcn_update_dpp(i, i, 0x141, 0xF, 0xF, false);
    else r = __builtin_amdgcn_update_dpp(i, i, 0x140, 0xF, 0xF, false);
    return __int_as_float(r); }
__device__ __forceinline__ float xsum16(float s) { const unsigned u = __float_as_uint(s); auto r = __builtin_amdgcn_permlane16_swap(u, u, false, false); return __uint_as_float(r[0]) + __uint_as_float(r[1]); }
__device__ __forceinline__ float xsum32(float s) { const unsigned u = __float_as_uint(s); auto r = __builtin_amdgcn_permlane32_swap(u, u, false, false); return __uint_as_float(r[0]) + __uint_as_float(r[1]); }
__device__ __forceinline__ float xmax32(float s) { const unsigned u = __float_as_uint(s); auto r = __builtin_amdgcn_permlane32_swap(u, u, false, false); return fmaxf(__uint_as_float(r[0]), __uint_as_float(r[1])); }
__device__ __forceinline__ float sum8(float v) { v += dpp_f(v, 0); v += dpp_f(v, 1); v += dpp_f(v, 2); return v; }
__device__ __forceinline__ float wave_sum(float v) { v = sum8(v); v += dpp_f(v, 3); v = xsum16(v); return xsum32(v); }
__device__ __forceinline__ float sigmoidf(float x) { return __builtin_amdgcn_rcpf(1.f + __builtin_amdgcn_exp2f(-x * LOG2E)); }
__device__ __forceinline__ float siluf(float x) { return x * sigmoidf(x); }
}

namespace pg8 {
constexpr int BM = 256, BK = 64, HALF = 128, HTB = HALF * BK * 2, STAGE_BYTES = 8 * HTB, NXCD = 8, WGM = 8;
__host__ __device__ __forceinline__ int lds_byte(int r, int c) { const int st = (r >> 4) * 2 + (c >> 5), rr = r & 15, cc = c & 31, ob = rr * 64 + cc * 2; return st * 1024 + (ob ^ (((ob >> 9) & 1) << 5)); }
__host__ __device__ __forceinline__ void stage_rc(int b, int& R, int& C) { const int st = b / 1024, sb = b % 1024, swz = sb ^ (((sb >> 9) & 1) << 5); R = (st >> 1) * 16 + swz / 64; C = (st & 1) * 32 + (swz % 64) / 2; }
__host__ __device__ __forceinline__ int perm32(int rho) { const int n = rho >> 4, i = rho & 15; return 8 * (i >> 2) + 4 * n + (i & 3); }

struct Unit { int pm, pn; const char* A; const char* B; int tag; int r0, rend, y0; };
__device__ __forceinline__ const char* uni_ptr(const char* p) { const unsigned long long v = (unsigned long long)p; const unsigned lo = __builtin_amdgcn_readfirstlane((unsigned)v), hi = __builtin_amdgcn_readfirstlane((unsigned)(v >> 32)); return (const char*)(((unsigned long long)hi << 32) | lo); }
struct Cfg { unsigned lda, ldb; int K; };

__device__ __forceinline__ bool static_tile(int i, int G, int c, int nM, int nN, int& pm, int& pn) {
    const int nwg = nM * nN; const long L = (long)i * G + c; if (L >= nwg) return false;
    int wgid = (int)L; { const int q = nwg / NXCD, r = nwg % NXCD, xcd = wgid % NXCD, off = wgid / NXCD; wgid = (xcd < r ? xcd * (q + 1) : r * (q + 1) + (xcd - r) * q) + off; }
    const int nig = WGM * nN, gid = wgid / nig, fm = gid * WGM, gsz = (nM - fm) < WGM ? (nM - fm) : WGM;
    pm = fm + ((wgid % nig) % gsz); pn = (wgid % nig) / gsz; return true;
}
struct DenseSched {
    int nM, nN, G, c; const char* A; const char* B; size_t tA, tB;
    __device__ __forceinline__ bool next(int i, Unit& u) const { if (!static_tile(i, G, c, nM, nN, u.pm, u.pn)) return false; u.A = A + (size_t)u.pm * tA; u.B = B + (size_t)u.pn * tB; u.tag = 0; return true; }
    __device__ __forceinline__ int row(const Unit&, int r) const { return r; }
};

template <class Epi, class Sched, bool GATHER>
__device__ __forceinline__ void gemm_phase(LAS unsigned char* lds, const Cfg g, const Sched& S, const Epi& E, int wv_) {
    int tid_ = wv_ * 64 + mk::lane_id(); asm volatile("" : "+v"(tid_));
    const int tid = tid_, wid = __builtin_amdgcn_readfirstlane(tid >> 6), lane = tid & 63, wr = wid >> 2, wc = wid & 3, fr = lane & 15, fq = lane >> 4;
    const int nt = g.K / BK;
    int RA[2], CA2[2]; unsigned vB[2], vAc[2][2], vAn[2][2];
#pragma unroll
    for (int i = 0; i < 2; ++i) { int R, C; stage_rc(tid * 16 + i * 8192, R, C); const int Rb = Epi::PERM ? (64 * (R >> 5) + 16 * ((R & 15) >> 2) + 4 * ((R >> 4) & 1) + (R & 3)) : R;
        RA[i] = R; CA2[i] = C * 2; vB[i] = (unsigned)Rb * g.ldb + (unsigned)C * 2u; }
    const size_t kstep = (size_t)(BK * 2);
    const size_t hB = (size_t)(Epi::PERM ? 8 : HALF) * g.ldb;
    const unsigned ldsw = (unsigned)wid * 1024u;
    const int aoff = lds_byte(wr * 64 + fr, fq * 8), boff = lds_byte(wc * 32 + fr, fq * 8);
#define PG8_SA(b, h) (((b) * 2 + (h)) * HTB)
#define PG8_SB(b, h) ((4 + (b) * 2 + (h)) * HTB)
#define PG8_STAGE(bufoff, gbase, voff) do { const char* _gb = uni_ptr((const char*)(gbase)); _Pragma("unroll") for (int _i = 0; _i < 2; ++_i) \
        __builtin_amdgcn_global_load_lds((const unsigned*)(_gb + (voff)[_i]), (LAS unsigned*)(lds + (bufoff) + ldsw + _i * 8192), 16, 0, 0); } while (0)
#define PG8_LDA(dst, b, h) do { _Pragma("unroll") for (int m = 0; m < 4; ++m) _Pragma("unroll") for (int k = 0; k < 2; ++k) dst[m][k] = *(const LAS bf16x8*)(lds + PG8_SA(b, h) + aoff + m * 2048 + k * 1024); } while (0)
#define PG8_LDB(dst, b, h) do { _Pragma("unroll") for (int n = 0; n < 2; ++n) _Pragma("unroll") for (int k = 0; k < 2; ++k) dst[n][k] = *(const LAS bf16x8*)(lds + PG8_SB(b, h) + boff + n * 2048 + k * 1024); } while (0)
#define PG8_MMA(ai, bj, At, Bt) do { __builtin_amdgcn_s_setprio(1); _Pragma("unroll") for (int m = 0; m < 4; ++m) _Pragma("unroll") for (int n = 0; n < 2; ++n) _Pragma("unroll") for (int k = 0; k < 2; ++k) \
        acc[ai][bj][m][n] = __builtin_amdgcn_mfma_f32_16x16x32_bf16(Bt[n][k], At[m][k], acc[ai][bj][m][n], 0, 0, 0); __builtin_amdgcn_s_setprio(0); } while (0)
#define PG8_WAIT_V(n) asm volatile("s_waitcnt vmcnt(" #n ")" ::: "memory")
#define PG8_WAIT_L(n) asm volatile("s_waitcnt lgkmcnt(" #n ")" ::: "memory")
#define PG8_BAR __builtin_amdgcn_s_barrier()
#define PG8_SCHED __builtin_amdgcn_sched_barrier(0)
#define PG8_VOFF(dst, u) do { _Pragma("unroll") for (int _h = 0; _h < 2; ++_h) _Pragma("unroll") for (int _i = 0; _i < 2; ++_i) \
        dst[_h][_i] = (unsigned)S.row(u, _h * HALF + RA[_i]) * g.lda + (unsigned)CA2[_i]; } while (0)
    Unit cur, nxt; int ui = 0;
    if (!S.next(0, cur)) return;
    f32x4 acc[2][2][4][2];
#pragma unroll
    for (int a = 0; a < 2; ++a)
#pragma unroll
        for (int b = 0; b < 2; ++b)
#pragma unroll
            for (int m = 0; m < 4; ++m)
#pragma unroll
                for (int n = 0; n < 2; ++n) acc[a][b][m][n] = (f32x4){0.f, 0.f, 0.f, 0.f};
    bf16x8 At[4][2], B0[2][2], B1[2][2];
    const char* cA = uni_ptr(cur.A); const char* cB = uni_ptr(cur.B);
    PG8_VOFF(vAc, cur);
    PG8_STAGE(PG8_SB(0, 0), cB, vB); PG8_STAGE(PG8_SB(0, 1), cB + hB, vB); PG8_STAGE(PG8_SA(0, 0), cA, vAc[0]); PG8_STAGE(PG8_SA(0, 1), cA, vAc[1]);
    if (wr == 1) PG8_BAR;
    PG8_WAIT_V(2); PG8_BAR;
    PG8_STAGE(PG8_SB(1, 0), cB + kstep, vB); PG8_STAGE(PG8_SA(1, 0), cA + kstep, vAc[0]); PG8_STAGE(PG8_SB(1, 1), cB + hB + kstep, vB);
    PG8_WAIT_V(6); PG8_BAR;
    for (;;) {
        const bool has_next = S.next(ui + 1, nxt);
        const char* nA = uni_ptr(has_next ? nxt.A : cA); const char* nB = uni_ptr(has_next ? nxt.B : cB);
        if constexpr (GATHER) { if (has_next) { PG8_VOFF(vAn, nxt); } else {
#pragma unroll
            for (int _h = 0; _h < 2; ++_h)
#pragma unroll
                for (int _i = 0; _i < 2; ++_i) vAn[_h][_i] = vAc[_h][_i]; } }
        for (int t = 0; t < nt; t += 2) {
            const bool last = (t == nt - 2);
            asm volatile("" : "+v"(vB[0]), "+v"(vB[1]), "+v"(vAc[0][0]), "+v"(vAc[0][1]), "+v"(vAc[1][0]), "+v"(vAc[1][1]));
            const char* a1 = cA + (size_t)(t + 1) * kstep;
            const char* a2 = uni_ptr(last ? nA : cA + (size_t)(t + 2) * kstep); const char* b2 = uni_ptr(last ? nB : cB + (size_t)(t + 2) * kstep);
            const char* a3 = a2 + kstep; const char* b3 = b2 + kstep;
            unsigned w0[2], w1[2];
#pragma unroll
            for (int _i = 0; _i < 2; ++_i) { if constexpr (GATHER) { w0[_i] = last ? vAn[0][_i] : vAc[0][_i]; w1[_i] = last ? vAn[1][_i] : vAc[1][_i]; } else { w0[_i] = vAc[0][_i]; w1[_i] = vAc[1][_i]; } }
            PG8_LDB(B0, 0, 0); PG8_LDB(B1, 0, 1); PG8_SCHED; PG8_LDA(At, 0, 0); PG8_STAGE(PG8_SA(1, 1), a1, vAc[1]);
            PG8_WAIT_V(8); PG8_WAIT_L(0); PG8_BAR; PG8_MMA(0, 0, At, B0); PG8_MMA(0, 1, At, B1); PG8_BAR; PG8_SCHED;
            PG8_LDA(At, 0, 1); PG8_STAGE(PG8_SB(0, 0), b2, vB); PG8_STAGE(PG8_SB(0, 1), b2 + hB, vB); PG8_STAGE(PG8_SA(0, 0), a2, w0);
            PG8_WAIT_V(8); PG8_WAIT_L(0); PG8_BAR; PG8_MMA(1, 0, At, B0); PG8_MMA(1, 1, At, B1); PG8_BAR; PG8_SCHED;
            PG8_LDB(B0, 1, 0); PG8_LDB(B1, 1, 1); PG8_SCHED; PG8_LDA(At, 1, 0); PG8_STAGE(PG8_SA(0, 1), a2, w1);
            PG8_WAIT_V(8); PG8_WAIT_L(0); PG8_BAR; PG8_MMA(0, 0, At, B0); PG8_MMA(0, 1, At, B1); PG8_BAR; PG8_SCHED;
            PG8_LDA(At, 1, 1); PG8_STAGE(PG8_SB(1, 0), b3, vB); PG8_STAGE(PG8_SB(1, 1), b3 + hB, vB); PG8_STAGE(PG8_SA(1, 0), a3, w0);
            PG8_WAIT_V(8); PG8_WAIT_L(0); PG8_BAR; PG8_MMA(1, 0, At, B0); PG8_MMA(1, 1, At, B1); PG8_BAR; PG8_SCHED;
        }
        if (wr == 0) PG8_BAR;
        const bool keep = E(acc, cur, wr, wc, fr, fq);
        if (!has_next) break;
        if (!keep) {
#pragma unroll
            for (int a = 0; a < 2; ++a)
#pragma unroll
                for (int b = 0; b < 2; ++b)
#pragma unroll
                    for (int m = 0; m < 4; ++m)
#pragma unroll
                        for (int n = 0; n < 2; ++n) acc[a][b][m][n] = (f32x4){0.f, 0.f, 0.f, 0.f};
        }
        cur = nxt; cA = nA; cB = nB; ++ui;
        if constexpr (GATHER) {
#pragma unroll
            for (int _h = 0; _h < 2; ++_h)
#pragma unroll
                for (int _i = 0; _i < 2; ++_i) vAc[_h][_i] = vAn[_h][_i]; }
        if (wr == 1) PG8_BAR;
    }
    PG8_WAIT_V(0);
    PG8_BAR;
#undef PG8_SA
#undef PG8_SB
#undef PG8_STAGE
#undef PG8_LDA
#undef PG8_LDB
#undef PG8_MMA
#undef PG8_WAIT_V
#undef PG8_WAIT_L
#undef PG8_BAR
#undef PG8_SCHED
#undef PG8_VOFF
}
}

namespace mk {
struct P {
    const float *x, *p, *g_mix, *w_in, *w_pool_mix, *pool_scale, *w_a, *q_gain, *k_gain, *sinks, *w_b, *w_gate, *b_gate, *w_out, *g_ffn, *w_router, *router_bias,
                *w_eg, *w_eu, *w_ed, *w_sg, *w_su, *w_sd, *g_ple, *w_pg, *w_pp, *g_post;
    float* out; char* ws;
};

struct RowBf { const bf16_t* base; int ld; __device__ __forceinline__ float4 load4(int r, int k) const { const uint2 v = *(const uint2*)(base + (size_t)r * ld + k);
    return make_float4(bf2f(v.x & 0xffffu), bf2f(v.x >> 16), bf2f(v.y & 0xffffu), bf2f(v.y >> 16)); } };
struct RowBfIdx { const bf16_t* base; int ld; const int* lst; int nvalid; int shift;
    __device__ __forceinline__ float4 load4(int r, int k) const { const int row = (r < nvalid ? lst[r] : lst[0]) >> shift; const uint2 v = *(const uint2*)(base + (size_t)row * ld + k);
    return make_float4(bf2f(v.x & 0xffffu), bf2f(v.x >> 16), bf2f(v.y & 0xffffu), bf2f(v.y >> 16)); } };
template <class ARow>
__device__ __forceinline__ void gemm_tile(int vt, ARow arow, const float* __restrict__ B, int ldb, int K, int n0, float (&acc)[4][4], float (*As)[68], float (*Bs)[64]) {
    const int tx = vt & 15, ty = vt >> 4;
#pragma unroll
    for (int i = 0; i < 4; ++i)
#pragma unroll
        for (int j = 0; j < 4; ++j) acc[i][j] = 0.f;
    const int ar = vt >> 2, ak = (vt & 3) * 4;
    const int bk = vt >> 4, bn = (vt & 15) * 4;
#pragma unroll 1
    for (int k0 = 0; k0 < K; k0 += 16) {
        const float4 av = arow.load4(ar, k0 + ak);
        const float4 bv = *(const float4*)(B + (size_t)(k0 + bk) * ldb + n0 + bn);
        __syncthreads();
        As[ak + 0][ar] = av.x; As[ak + 1][ar] = av.y; As[ak + 2][ar] = av.z; As[ak + 3][ar] = av.w;
        *(float4*)&Bs[bk][bn] = bv;
        __syncthreads();
#pragma unroll
        for (int kk = 0; kk < 16; ++kk) {
            const float4 a = *(const float4*)&As[kk][ty * 4];
            const float4 b = *(const float4*)&Bs[kk][tx * 4];
            const float aa[4] = {a.x, a.y, a.z, a.w}, bb[4] = {b.x, b.y, b.z, b.w};
#pragma unroll
            for (int i = 0; i < 4; ++i)
#pragma unroll
                for (int j = 0; j < 4; ++j) acc[i][j] += aa[i] * bb[j];
        }
    }
}
#define VB_LOOP(nvb) for (int _it = 0, _nit = ((nvb) + 2 * (int)gridDim.x - 1) / (2 * (int)gridDim.x); _it < _nit; ++_it) { \
    const int _raw = _it * 2 * (int)gridDim.x + (int)blockIdx.x * 2 + half; const bool vvalid = _raw < (nvb); const int vb = vvalid ? _raw : 0;
#define VB_END }
#define FOR_IJ _Pragma("unroll") for (int i = 0; i < 4; ++i) _Pragma("unroll") for (int j = 0; j < 4; ++j)

struct TItem { const float* src; int ld; bf16_t* dst; int ldk; const float* ks; int gu; };
__device__ __forceinline__ TItem ti_plain(const float* W, int K, int N, bf16_t* dstm, int row_off, int item, const float* kscale = nullptr) {
    const int nblk = N / 32, kb = item / nblk, nb = item % nblk;
    return TItem{W + (size_t)(64 * kb) * N + 32 * nb, N, dstm + (size_t)(row_off + 32 * nb) * K + 64 * kb, K, kscale ? kscale + 64 * kb : nullptr, 0}; }
__device__ __forceinline__ TItem ti_gu(const float* W, bf16_t* dstm, int up, int item, const float* kscale) {
    const int kb = item / 8, nb = item % 8, c0 = 32 * nb;
    return TItem{W + (size_t)(64 * kb) * 256 + c0, 256, dstm + (size_t)((c0 >> 7) * 256 + 2 * (c0 & 127) + 8 * up) * 1024 + 64 * kb, 1024, kscale + 64 * kb, 1}; }
__device__ __forceinline__ TItem ti_gate(const float* W, bf16_t* wcat, int item) {
    const int kb = item / 64, nb = item % 64, c0 = 32 * nb, ab = c0 >> 10, oc = c0 & 1023;
    return TItem{W + (size_t)(64 * kb) * (2 * D) + c0, 2 * D, wcat + (size_t)(IND + 256 * (oc >> 7) + 2 * (oc & 127) + 8 * ab) * D + 64 * kb, D, nullptr, 1}; }
__device__ __forceinline__ void ti_load(const TItem& t, f32x4 (&v)[8], int lane) {
#pragma unroll
    for (int i = 0; i < 8; ++i) { v[i] = *(const f32x4*)(t.src + (size_t)(8 * (lane >> 3) + i) * t.ld + 4 * (lane & 7)); if (t.ks) v[i] = v[i] * t.ks[8 * (lane >> 3) + i]; } }
__device__ __forceinline__ void ti_finish(const TItem& t, const f32x4 (&v)[8], LAS float*, int lane) {
#pragma unroll
    for (int j = 0; j < 4; ++j) { u32x4 o; o.x = pk2(v[0][j], v[1][j]); o.y = pk2(v[2][j], v[3][j]); o.z = pk2(v[4][j], v[5][j]); o.w = pk2(v[6][j], v[7][j]);
        const int n_ = 4 * (lane & 7) + j; *(u32x4*)(t.dst + (size_t)(t.gu ? 2 * (n_ & ~7) + (n_ & 7) : n_) * t.ldk + 8 * (lane >> 3)) = o; }
}

struct EpiG1 {
    static constexpr bool PERM = true;
    bf16_t* u; bf16_t* gates; const float* bg;
    __device__ __forceinline__ bool operator()(f32x4 (&acc)[2][2][4][2], const pg8::Unit& un, int wr, int wc, int fr, int fq) const {
        const int row0 = un.pm * 256 + wr * 64 + fr;
        if (un.pn < 5) { const int col0 = un.pn * 256 + wc * 64 + 16 * fq;
#pragma unroll
            for (int ai = 0; ai < 2; ++ai)
#pragma unroll
                for (int m = 0; m < 4; ++m) { bf16_t* rowp = u + (size_t)(row0 + ai * 128 + m * 16) * IND + col0;
#pragma unroll
                    for (int bj = 0; bj < 2; ++bj) { const f32x4 v0 = acc[ai][bj][m][0], v1 = acc[ai][bj][m][1];
                        u32x4 w; w.x = cvt_pk_bf16(v0[0], v0[1]); w.y = cvt_pk_bf16(v0[2], v0[3]); w.z = cvt_pk_bf16(v1[0], v1[1]); w.w = cvt_pk_bf16(v1[2], v1[3]);
                        *(u32x4*)(rowp + bj * 8) = w; } }
        } else { const int c0 = (un.pn - 5) * 128 + wc * 32 + 8 * fq;
            const f32x4 ba0 = *(const f32x4*)(bg + c0), ba1 = *(const f32x4*)(bg + c0 + 4), bb0 = *(const f32x4*)(bg + D + c0), bb1 = *(const f32x4*)(bg + D + c0 + 4);
#pragma unroll
            for (int ai = 0; ai < 2; ++ai)
#pragma unroll
                for (int m = 0; m < 4; ++m) { bf16_t* rowp = gates + (size_t)(row0 + ai * 128 + m * 16) * 2 * D + c0;
                    const f32x4 za0 = acc[ai][0][m][0] + ba0, za1 = acc[ai][0][m][1] + ba1, zb0 = acc[ai][1][m][0] + bb0, zb1 = acc[ai][1][m][1] + bb1;
                    f32x4 r0, r1, g0, g1;
#pragma unroll
                    for (int q = 0; q < 4; ++q) { g0[q] = sigmoidf(zb0[q]); g1[q] = sigmoidf(zb1[q]);
                        r0[q] = sigmoidf(za0[q]) * __builtin_amdgcn_rcpf(fmaxf(g0[q], 1e-12f)); r1[q] = sigmoidf(za1[q]) * __builtin_amdgcn_rcpf(fmaxf(g1[q], 1e-12f)); }
                    u32x4 w; w.x = cvt_pk_bf16(r0[0], r0[1]); w.y = cvt_pk_bf16(r0[2], r0[3]); w.z = cvt_pk_bf16(r1[0], r1[1]); w.w = cvt_pk_bf16(r1[2], r1[3]);
                    *(u32x4*)rowp = w;
                    w.x = cvt_pk_bf16(g0[0], g0[1]); w.y = cvt_pk_bf16(g0[2], g0[3]); w.z = cvt_pk_bf16(g1[0], g1[1]); w.w = cvt_pk_bf16(g1[2], g1[3]);
                    *(u32x4*)(rowp + D) = w; } }
        return false;
    }
};
struct EpiPP {
    static constexpr bool PERM = true;
    bf16_t* pp; float* rss;
    __device__ __forceinline__ bool operator()(f32x4 (&acc)[2][2][4][2], const pg8::Unit& un, int wr, int wc, int fr, int fq) const {
        const int row0 = un.pm * 256 + wr * 64 + fr, col0 = un.pn * 256 + wc * 64 + 16 * fq;
#pragma unroll
        for (int ai = 0; ai < 2; ++ai)
#pragma unroll
            for (int m = 0; m < 4; ++m) { const int row = row0 + ai * 128 + m * 16; bf16_t* rowp = pp + (size_t)row * D + col0; float s = 0.f;
#pragma unroll
                for (int bj = 0; bj < 2; ++bj) { const f32x4 v0 = acc[ai][bj][m][0], v1 = acc[ai][bj][m][1];
                    s += (v0[0] * v0[0] + v0[1] * v0[1]) + (v0[2] * v0[2] + v0[3] * v0[3]) + (v1[0] * v1[0] + v1[1] * v1[1]) + (v1[2] * v1[2] + v1[3] * v1[3]);
                    u32x4 w; w.x = cvt_pk_bf16(v0[0], v0[1]); w.y = cvt_pk_bf16(v0[2], v0[3]); w.z = cvt_pk_bf16(v1[0], v1[1]); w.w = cvt_pk_bf16(v1[2], v1[3]);
                    *(u32x4*)(rowp + bj * 8) = w; }
                s = xsum32(xsum16(s));
                if (fq == 0) atomicAdd(rss + row, s); }
        return false;
    }
};


struct EpiBf16Plain {
    static constexpr bool PERM = true;
    bf16_t* O; int ld;
    __device__ __forceinline__ bool operator()(f32x4 (&acc)[2][2][4][2], const pg8::Unit& un, int wr, int wc, int fr, int fq) const {
        const int row0 = un.pm * 256 + wr * 64 + fr, col0 = un.pn * 256 + wc * 64 + 16 * fq;
#pragma unroll
        for (int ai = 0; ai < 2; ++ai)
#pragma unroll
            for (int m = 0; m < 4; ++m) { bf16_t* rowp = O + (size_t)(row0 + ai * 128 + m * 16) * ld + col0;
#pragma unroll
                for (int bj = 0; bj < 2; ++bj) { const f32x4 v0 = acc[ai][bj][m][0], v1 = acc[ai][bj][m][1];
                    u32x4 w; w.x = cvt_pk_bf16(v0[0], v0[1]); w.y = cvt_pk_bf16(v0[2], v0[3]); w.z = cvt_pk_bf16(v1[0], v1[1]); w.w = cvt_pk_bf16(v1[2], v1[3]);
                    *(u32x4*)(rowp + bj * 8) = w; } }
        return false;
    }
};
struct PPSched {
    int G, c; const char* A; const char* B;
    __device__ __forceinline__ bool next(int i, pg8::Unit& u) const {
        if (G != 256) { if (!pg8::static_tile(i, G, c, T / 256, D / 256, u.pm, u.pn)) return false; }
        else { int idx; if (c < 128) { if (i > 0) return false; idx = c; } else { if (i > 2) return false; idx = 128 + (c - 128) * 3 + i; } u.pm = idx >> 2; u.pn = idx & 3; }
        u.A = A + (size_t)u.pm * 256 * PLE * 2; u.B = B + (size_t)u.pn * 256 * PLE * 2; u.tag = 0; return true; }
    __device__ __forceinline__ int row(const pg8::Unit&, int r) const { return r; }
};
struct P6Sched {
    int G, c; const char* A; const char* B;
    __device__ __forceinline__ bool next(int i, pg8::Unit& u) const {
        if (G != 256) { if (!pg8::static_tile(i, G, c, T / 256, 3, u.pm, u.pn)) return false; }
        else if (c < 128) { if (i > 0) return false; u.pm = c; u.pn = 2; }
        else { if (i > 1) return false; const int idx = (c - 128) * 2 + i; u.pm = idx >> 1; u.pn = idx & 1; }
        u.A = A + (size_t)u.pm * 256 * D * 2; u.B = B + (size_t)u.pn * 256 * D * 2; u.tag = 0; return true; }
    __device__ __forceinline__ int row(const pg8::Unit&, int r) const { return r; }
};
struct MixSched {
    int G, c; const char* A; const char* B;
    __device__ __forceinline__ bool next(int i, pg8::Unit& u) const { if (!pg8::static_tile(i, G, c, T / 256, 2, u.pm, u.pn)) return false;
        u.A = A + (size_t)u.pm * 256 * POOLD * 2 + (size_t)u.pn * 512; u.B = B + (size_t)u.pn * 256 * 256 * 2; u.tag = 0; return true; }
    __device__ __forceinline__ int row(const pg8::Unit&, int r) const { return r; }
};
struct MergedSched {
    int G, c; const char* A0; const char* A1; const char* B0; const char* B1;
    __device__ __forceinline__ bool next(int i, pg8::Unit& u) const { if (!pg8::static_tile(i >> 1, G, c, T / 256, D / 256, u.pm, u.pn)) return false;
        const int br = i & 1; u.A = (br ? A1 : A0) + (size_t)u.pm * 256 * 512 * 2; u.B = (br ? B1 : B0) + (size_t)u.pn * 256 * 512 * 2; u.tag = br; return true; }
    __device__ __forceinline__ int row(const pg8::Unit&, int r) const { return r; }
};
struct EpiMerged {
    static constexpr bool PERM = true;
    const bf16_t* gates; bf16_t* O;
    __device__ __forceinline__ bool operator()(f32x4 (&acc)[2][2][4][2], const pg8::Unit& un, int wr, int wc, int fr, int fq) const {
        const int row0 = un.pm * 256 + wr * 64 + fr, col0 = un.pn * 256 + wc * 64 + 16 * fq;
        u32x4 gv[8][2];
#pragma unroll
        for (int j = 0; j < 8; ++j)
#pragma unroll
            for (int bj = 0; bj < 2; ++bj) gv[j][bj] = *(const u32x4*)(gates + (size_t)(row0 + (j >> 2) * 128 + (j & 3) * 16) * 2 * D + (un.tag == 0 ? 0 : D) + col0 + bj * 8);
#pragma unroll
        for (int ai = 0; ai < 2; ++ai)
#pragma unroll
            for (int m = 0; m < 4; ++m) { const size_t row = (size_t)(row0 + ai * 128 + m * 16);
#pragma unroll
                for (int bj = 0; bj < 2; ++bj) { const u32x4 g4 = gv[ai * 4 + m][bj];
                    const float gf[8] = {bf2f(g4.x & 0xffffu), bf2f(g4.x >> 16), bf2f(g4.y & 0xffffu), bf2f(g4.y >> 16), bf2f(g4.z & 0xffffu), bf2f(g4.z >> 16), bf2f(g4.w & 0xffffu), bf2f(g4.w >> 16)};
                    if (un.tag == 0) {
#pragma unroll
                        for (int q = 0; q < 4; ++q) { acc[ai][bj][m][0][q] *= gf[q]; acc[ai][bj][m][1][q] *= gf[4 + q]; }
                    } else { const f32x4 v0 = acc[ai][bj][m][0], v1 = acc[ai][bj][m][1];
                        u32x4 w; w.x = cvt_pk_bf16(v0[0] * gf[0], v0[1] * gf[1]); w.y = cvt_pk_bf16(v0[2] * gf[2], v0[3] * gf[3]); w.z = cvt_pk_bf16(v1[0] * gf[4], v1[1] * gf[5]); w.w = cvt_pk_bf16(v1[2] * gf[6], v1[3] * gf[7]);
                        *(u32x4*)(O + row * D + col0 + bj * 8) = w; } } }
        return un.tag == 0;
    }
};
struct EpiResid {
    static constexpr bool PERM = true;
    const float* x; bf16_t* xb; float* rss;
    __device__ __forceinline__ bool operator()(f32x4 (&acc)[2][2][4][2], const pg8::Unit& un, int wr, int wc, int fr, int fq) const {
        const int row0 = un.pm * 256 + wr * 64 + fr, col0 = un.pn * 256 + wc * 64 + 16 * fq;
        f32x4 xv[2][4][2][2];
#pragma unroll
        for (int m = 0; m < 4; ++m)
#pragma unroll
            for (int bj = 0; bj < 2; ++bj) { const float* xp = x + (size_t)(row0 + m * 16) * D + col0 + bj * 8; xv[0][m][bj][0] = *(const f32x4*)xp; xv[0][m][bj][1] = *(const f32x4*)(xp + 4); }
#pragma unroll
        for (int ai = 0; ai < 2; ++ai) {
            u32x4 wv[4][2]; float sv[4];
#pragma unroll
            for (int m = 0; m < 4; ++m) { float s_ = 0.f;
#pragma unroll
                for (int bj = 0; bj < 2; ++bj) { const f32x4 v0 = xv[ai][m][bj][0] + acc[ai][bj][m][0], v1 = xv[ai][m][bj][1] + acc[ai][bj][m][1];
                    s_ += (v0[0] * v0[0] + v0[1] * v0[1]) + (v0[2] * v0[2] + v0[3] * v0[3]) + (v1[0] * v1[0] + v1[1] * v1[1]) + (v1[2] * v1[2] + v1[3] * v1[3]);
                    wv[m][bj].x = cvt_pk_bf16(v0[0], v0[1]); wv[m][bj].y = cvt_pk_bf16(v0[2], v0[3]); wv[m][bj].z = cvt_pk_bf16(v1[0], v1[1]); wv[m][bj].w = cvt_pk_bf16(v1[2], v1[3]); }
                sv[m] = xsum32(xsum16(s_)); }
            if (ai == 0) {
#pragma unroll
                for (int m = 0; m < 4; ++m)
#pragma unroll
                    for (int bj = 0; bj < 2; ++bj) { const float* xp = x + (size_t)(row0 + 128 + m * 16) * D + col0 + bj * 8; xv[1][m][bj][0] = *(const f32x4*)xp; xv[1][m][bj][1] = *(const f32x4*)(xp + 4); } }
#pragma unroll
            for (int m = 0; m < 4; ++m) { const int row = row0 + ai * 128 + m * 16;
#pragma unroll
                for (int bj = 0; bj < 2; ++bj) *(u32x4*)(xb + (size_t)row * D + col0 + bj * 8) = wv[m][bj];
                if (fq == 0) atomicAdd(rss + row, sv[m]); }
        }
        return false;
    }
};
struct EpiShared {
    static constexpr bool PERM = true;
    bf16_t* act; float* lg; const float* rss;
    __device__ __forceinline__ bool operator()(f32x4 (&acc)[2][2][4][2], const pg8::Unit& un, int wr, int wc, int fr, int fq) const {
        const int row0 = un.pm * 256 + wr * 64 + fr;
        float rs8[8];
#pragma unroll
        for (int j = 0; j < 8; ++j) rs8[j] = rss[row0 + (j >> 2) * 128 + (j & 3) * 16];
#pragma unroll
        for (int j = 0; j < 8; ++j) rs8[j] = rsqrtf(rs8[j] * (1.f / D) + EPS);
#pragma unroll
        for (int ai = 0; ai < 2; ++ai)
#pragma unroll
            for (int m = 0; m < 4; ++m) { const int row = row0 + ai * 128 + m * 16; const float rs = rs8[ai * 4 + m];
                if (un.pn < 2) { const f32x4 g0 = acc[ai][0][m][0] * rs, g1 = acc[ai][0][m][1] * rs, u0 = acc[ai][1][m][0] * rs, u1 = acc[ai][1][m][1] * rs;
                    u32x4 w; w.x = cvt_pk_bf16(siluf(g0[0]) * u0[0], siluf(g0[1]) * u0[1]); w.y = cvt_pk_bf16(siluf(g0[2]) * u0[2], siluf(g0[3]) * u0[3]);
                    w.z = cvt_pk_bf16(siluf(g1[0]) * u1[0], siluf(g1[1]) * u1[1]); w.w = cvt_pk_bf16(siluf(g1[2]) * u1[2], siluf(g1[3]) * u1[3]);
                    *(u32x4*)(act + (size_t)row * SD + un.pn * 128 + wc * 32 + 8 * fq) = w;
                } else if (wc == 0) { float* lp = lg + (size_t)row * NE + 16 * fq;
                    *(f32x4*)lp = acc[ai][0][m][0] * rs; *(f32x4*)(lp + 4) = acc[ai][0][m][1] * rs; *(f32x4*)(lp + 8) = acc[ai][1][m][0] * rs; *(f32x4*)(lp + 12) = acc[ai][1][m][1] * rs; } }
        return false;
    }
};
struct EpiFinal {
    static constexpr bool PERM = true;
    float* o; const bf16_t* x2; const bf16_t* pp; const float* rss3_; const float* rsspp_; const float* gp;
    __device__ __forceinline__ bool operator()(f32x4 (&acc)[2][2][4][2], const pg8::Unit& un, int wr, int wc, int fr, int fq) const {
        const int row0 = un.pm * 256 + wr * 64 + fr, col0 = un.pn * 256 + wc * 64 + 16 * fq;
        f32x4 gv[2][2];
#pragma unroll
        for (int bj = 0; bj < 2; ++bj)
#pragma unroll
            for (int n = 0; n < 2; ++n) gv[bj][n] = *(const f32x4*)(gp + col0 + bj * 8 + n * 4);
        u32x4 xv[2][4][2], pv[2][4][2]; float r3[2][4], rp[2][4];
#define EF_LOAD(ai_) do { _Pragma("unroll") for (int m = 0; m < 4; ++m) { const int row = row0 + (ai_) * 128 + m * 16; r3[ai_][m] = rss3_[row]; rp[ai_][m] = rsspp_[row]; \
        _Pragma("unroll") for (int bj = 0; bj < 2; ++bj) { const size_t o2 = (size_t)row * D + col0 + bj * 8; xv[ai_][m][bj] = *(const u32x4*)(x2 + o2); pv[ai_][m][bj] = *(const u32x4*)(pp + o2); } } } while (0)
        EF_LOAD(0);
#pragma unroll
        for (int ai = 0; ai < 2; ++ai) {
            f32x4 res[4][2][2];
#pragma unroll
            for (int m = 0; m < 4; ++m) { const float q3 = rsqrtf(r3[ai][m] * (1.f / D) + EPS), qp = rsqrtf(rp[ai][m] * (1.f / D) + EPS);
#pragma unroll
                for (int bj = 0; bj < 2; ++bj) { const u32x4 xq = xv[ai][m][bj], pq = pv[ai][m][bj]; const f32x4 a0 = acc[ai][bj][m][0] * q3, a1 = acc[ai][bj][m][1] * q3; f32x4 v0, v1;
                    v0[0] = bf2f(xq.x & 0xffffu) + sigmoidf(a0[0]) * bf2f(pq.x & 0xffffu) * qp * gv[bj][0][0]; v0[1] = bf2f(xq.x >> 16) + sigmoidf(a0[1]) * bf2f(pq.x >> 16) * qp * gv[bj][0][1];
                    v0[2] = bf2f(xq.y & 0xffffu) + sigmoidf(a0[2]) * bf2f(pq.y & 0xffffu) * qp * gv[bj][0][2]; v0[3] = bf2f(xq.y >> 16) + sigmoidf(a0[3]) * bf2f(pq.y >> 16) * qp * gv[bj][0][3];
                    v1[0] = bf2f(xq.z & 0xffffu) + sigmoidf(a1[0]) * bf2f(pq.z & 0xffffu) * qp * gv[bj][1][0]; v1[1] = bf2f(xq.z >> 16) + sigmoidf(a1[1]) * bf2f(pq.z >> 16) * qp * gv[bj][1][1];
                    v1[2] = bf2f(xq.w & 0xffffu) + sigmoidf(a1[2]) * bf2f(pq.w & 0xffffu) * qp * gv[bj][1][2]; v1[3] = bf2f(xq.w >> 16) + sigmoidf(a1[3]) * bf2f(pq.w >> 16) * qp * gv[bj][1][3];
                    res[m][bj][0] = v0; res[m][bj][1] = v1; } }
            if (ai == 0) EF_LOAD(1);
#pragma unroll
            for (int m = 0; m < 4; ++m)
#pragma unroll
                for (int bj = 0; bj < 2; ++bj) { float* op = o + (size_t)(row0 + ai * 128 + m * 16) * D + col0 + bj * 8; *(f32x4*)op = res[m][bj][0]; *(f32x4*)(op + 4) = res[m][bj][1]; }
        }
#undef EF_LOAD
        return false;
    }
};
__device__ __forceinline__ int find_expert(const LAS int* mts, int mt) { int e = 0;
#pragma unroll 1
    for (; e < NE - 1; ++e) if (mt < mts[e + 1]) break;
    return e; }
struct RoutedUpSched {
    int G, c, nM; const LAS unsigned char* t2e; const int* tl; const char* A; const char* B;
    __device__ __forceinline__ bool next(int i, pg8::Unit& u) const { if (!pg8::static_tile(i, G, c, nM, 2, u.pm, u.pn)) return false;
        const int e = t2e[u.pm]; u.A = A; u.B = B + (size_t)e * 512 * D * 2 + (size_t)u.pn * 256 * D * 2; u.tag = e; return true; }
    __device__ __forceinline__ int row(const pg8::Unit& u, int r) const { const int aid = tl[u.pm * 256 + r]; return aid < 0 ? 0 : (aid >> 3); }
};
struct EpiRoutedUp {
    static constexpr bool PERM = true;
    bf16_t* act; const int2* ri; const float* wt;
    __device__ __forceinline__ bool operator()(f32x4 (&acc)[2][2][4][2], const pg8::Unit& un, int wr, int wc, int fr, int fq) const {
        const int row0 = un.pm * 256 + wr * 64 + fr;
        float rs8[8], w8[8];
#pragma unroll
        for (int j = 0; j < 8; ++j) { const int pos = row0 + (j >> 2) * 128 + (j & 3) * 16; rs8[j] = __int_as_float(ri[pos].y); w8[j] = wt[pos]; }
#pragma unroll
        for (int ai = 0; ai < 2; ++ai)
#pragma unroll
            for (int m = 0; m < 4; ++m) { const int pos = row0 + ai * 128 + m * 16; const float rs = rs8[ai * 4 + m], rw = rs * w8[ai * 4 + m];
                const f32x4 g0 = acc[ai][0][m][0] * rs, g1 = acc[ai][0][m][1] * rs, u0 = acc[ai][1][m][0] * rw, u1 = acc[ai][1][m][1] * rw;
                u32x4 o; o.x = cvt_pk_bf16(siluf(g0[0]) * u0[0], siluf(g0[1]) * u0[1]); o.y = cvt_pk_bf16(siluf(g0[2]) * u0[2], siluf(g0[3]) * u0[3]);
                o.z = cvt_pk_bf16(siluf(g1[0]) * u1[0], siluf(g1[1]) * u1[1]); o.w = cvt_pk_bf16(siluf(g1[2]) * u1[2], siluf(g1[3]) * u1[3]);
                *(u32x4*)(act + (size_t)pos * ED + un.pn * 128 + wc * 32 + 8 * fq) = o; }
        return false;
    }
};
struct DownSched {
    int G, c, r; const LAS int* lo; const LAS int* tst; const LAS unsigned char* t2e; const LAS int* cb; const char* Ar; const char* As_; const char* Br; const char* Bs_;
    __device__ __forceinline__ bool next(int i, pg8::Unit& u) const { const LAS int* ts = tst + r * 65; const int ntl = ts[64];
        if (!pg8::static_tile(i, G, c, ntl + TR / 256, 4, u.pm, u.pn)) return false;
        if (u.pm < ntl) { const int e = t2e[r * T2S + u.pm]; const int row0 = lo[r * 64 + e] + 256 * (u.pm - ts[e]);
            u.A = Ar + (size_t)row0 * ED * 2; u.B = Br + (size_t)e * D * ED * 2 + (size_t)u.pn * 256 * ED * 2; u.tag = 0; u.r0 = row0; u.rend = lo[(r + 1) * 64 + e]; u.y0 = cb[r * 64 + e] + 256 * (u.pm - ts[e]); }
        else { const int t0 = r * TR + 256 * (u.pm - ntl); u.A = As_ + (size_t)t0 * SD * 2; u.B = Bs_ + (size_t)u.pn * 256 * SD * 2; u.tag = 1; u.r0 = t0; u.rend = t0 + 256; u.y0 = 8 * TR + 256 * (u.pm - ntl); }
        return true; }
    __device__ __forceinline__ int row(const pg8::Unit&, int r_) const { return r_; }
};
__device__ __forceinline__ unsigned pack_fp8x4(f32x4 v) {
    const float a0 = __builtin_amdgcn_fmed3f(v[0], -448.f, 448.f), a1 = __builtin_amdgcn_fmed3f(v[1], -448.f, 448.f), a2 = __builtin_amdgcn_fmed3f(v[2], -448.f, 448.f), a3 = __builtin_amdgcn_fmed3f(v[3], -448.f, 448.f);
    int w = __builtin_amdgcn_cvt_pk_fp8_f32(a0, a1, 0, false); w = __builtin_amdgcn_cvt_pk_fp8_f32(a2, a3, w, true); return (unsigned)w; }
struct EpiDown {
    static constexpr bool PERM = true;
    unsigned char* Y;
    __device__ __forceinline__ bool operator()(f32x4 (&acc)[2][2][4][2], const pg8::Unit& un, int wr, int wc, int fr, int fq) const {
        const int rl0 = wr * 64 + fr;
#pragma unroll
        for (int ai = 0; ai < 2; ++ai)
#pragma unroll
            for (int m = 0; m < 4; ++m) { const int rl = rl0 + ai * 128 + m * 16;
                if (un.r0 + rl < un.rend) { unsigned char* yr = Y + (size_t)(un.y0 + rl) * 1024 + un.pn * 256 + wc * 64 + 16 * fq;
                    u32x4 o; o.x = pack_fp8x4(acc[ai][0][m][0]); o.y = pack_fp8x4(acc[ai][0][m][1]); o.z = pack_fp8x4(acc[ai][1][m][0]); o.w = pack_fp8x4(acc[ai][1][m][1]); *(u32x4*)yr = o; } }
        return false;
    }
};

#define XB_TMO      128
#define XB_XCNT(j)  (256  + 64 * (j))
#define XB_XSUB(j)  (1280 + 64 * (j))
#define XB_XGEN(j)  (2304 + 64 * (j))
#define XB_TOP      3328
#define XB_TOPGEN   3392
#define XCD_BAR_WORDS 3456
#define XB_SPIN_CAP (1u << 22)
__device__ __forceinline__ unsigned xb_ld(unsigned* p)              { return __hip_atomic_load(p, __ATOMIC_RELAXED, __HIP_MEMORY_SCOPE_AGENT); }
__device__ __forceinline__ unsigned xb_add(unsigned* p, unsigned v) { return __hip_atomic_fetch_add(p, v, __ATOMIC_RELAXED, __HIP_MEMORY_SCOPE_AGENT); }
__device__ __forceinline__ unsigned xb_xcc_id() { return (unsigned)__builtin_amdgcn_s_getreg((3 << 11) | 20) & 0xFu; }
#define XB_SPIN(cond, bar) do { unsigned _sp = 0; while (cond) { __builtin_amdgcn_s_sleep(1); \
    if ((++_sp & 255u) == 0u) { if (xb_ld(&(bar)[XB_TMO])) break; if (_sp > XB_SPIN_CAP) { atomicAdd(&(bar)[XB_TMO], 1u); break; } } } } while (0)
struct XcdBarrier { unsigned* bar; unsigned x; volatile LAS unsigned* st; };
__device__ __forceinline__ XcdBarrier xcd_barrier_post(unsigned* bar, volatile LAS unsigned* st, bool first_wave) {
    XcdBarrier b; b.bar = bar; b.x = xb_xcc_id(); b.st = st;
    if (lane_id() == 0 && first_wave) (void)xb_add(&bar[XB_XCNT(b.x)], 1u);
    return b;
}
__device__ __forceinline__ void xcd_barrier_complete(unsigned* bar, unsigned x, unsigned& nloc, unsigned& nx) {
    const unsigned G = gridDim.x * gridDim.y * gridDim.z;
    unsigned sum, cnt, mine, sp = 0u;
    for (;;) {
        sum = 0u; cnt = 0u; mine = 0u;
#pragma unroll
        for (unsigned j = 0; j < 16; ++j) { const unsigned c = xb_ld(&bar[XB_XCNT(j)]); sum += c; cnt += (c > 0u) ? 1u : 0u; mine = (j == x) ? c : mine; }
        if (sum == G) break;
        __builtin_amdgcn_s_sleep(1);
        if ((++sp & 255u) == 0u) { if (xb_ld(&bar[XB_TMO])) break; if (sp > XB_SPIN_CAP) { atomicAdd(&bar[XB_TMO], 1u); break; } }
    }
    nloc = mine > 0u ? mine : 1u; nx = cnt > 0u ? cnt : 1u;
}
__device__ __forceinline__ void xcd_barrier(const XcdBarrier& b, int tid) {
    asm volatile("s_waitcnt vmcnt(0)" ::: "memory");
    __syncthreads();
    if (tid == 0) {
        unsigned* bar = b.bar; unsigned bx = b.x; asm volatile("" : "+s"(bx));
        __builtin_amdgcn_s_waitcnt(0);
        unsigned nloc = b.st[0], nx = b.st[1];
        if (nloc == 0u) { xcd_barrier_complete(bar, bx, nloc, nx); b.st[0] = nloc; b.st[1] = nx; }
        const unsigned old = xb_add(&bar[XB_XSUB(bx)], 1u);
        const unsigned gen = old / nloc;
        if (old + 1u == (gen + 1u) * nloc) {
            __builtin_amdgcn_fence(__ATOMIC_RELEASE, "agent");
            asm volatile("s_waitcnt vmcnt(0)" ::: "memory");
            const unsigned og = xb_add(&bar[XB_TOP], 1u);
            const unsigned tg = og / nx;
            if (og + 1u == (tg + 1u) * nx) xb_add(&bar[XB_TOPGEN], 1u);
            else XB_SPIN(xb_ld(&bar[XB_TOPGEN]) == tg, bar);
            __builtin_amdgcn_fence(__ATOMIC_ACQUIRE, "agent");
            xb_add(&bar[XB_XGEN(bx)], 1u);
            asm volatile("s_waitcnt vmcnt(0)" ::: "memory");
        } else {
            XB_SPIN(xb_ld(&bar[XB_XGEN(bx)]) == gen, bar);
            __builtin_amdgcn_fence(__ATOMIC_ACQUIRE, "agent");
            asm volatile("s_waitcnt vmcnt(0)" ::: "memory");
        }
    }
    __syncthreads();
}

typedef float f32x16 __attribute__((ext_vector_type(16)));
typedef short s16x4 __attribute__((ext_vector_type(4)));
__device__ __forceinline__ void attn_phase(LAS unsigned char* lds, const bf16_t* __restrict__ u, bf16_t* __restrict__ attn, const float* __restrict__ sinks, const float* __restrict__ qg, const float* __restrict__ kg, int G, int wv_) {
    int tid_ = wv_ * 64 + lane_id(); asm volatile("" : "+v"(tid_));
    const int tid = tid_, lane = tid & 63, wave = __builtin_amdgcn_readfirstlane(tid >> 6), r32 = lane & 31, hi = lane >> 5;
    u32x4 kreg[4], vreg[4];
#define ATT_LOAD(un_) do { const int kvh_ = (un_) & 1, t0_ = ((un_) >> 1) * 128; _Pragma("unroll") for (int it = 0; it < 4; ++it) { const int i = tid + it * NT, j = i >> 3, ch = i & 7; int tok = t0_ - 128 + j; tok = tok < 0 ? 0 : tok; \
        kreg[it] = *(const u32x4*)(u + (size_t)tok * IND + POOLD + QD + kvh_ * 64 + ch * 8); vreg[it] = *(const u32x4*)(u + (size_t)tok * IND + POOLD + QD + KVD + kvh_ * 64 + ch * 8); } } while (0)
    if ((int)blockIdx.x < (T / 128) * 2) ATT_LOAD((int)blockIdx.x);
    for (int un = blockIdx.x; un < (T / 128) * 2; un += G) {
        const int kvh = un & 1, blk = un >> 1, t0 = blk * 128; const bool first = (t0 % SEQ) == 0;
#pragma unroll
        for (int it = 0; it < 4; ++it) { const int i = tid + it * NT, j = i >> 3, ch = i & 7;
            u32x4 kk = kreg[it]; const u32x4 vv = vreg[it];
            {
                float f[8] = {bf2f(kk.x & 0xffffu), bf2f(kk.x >> 16), bf2f(kk.y & 0xffffu), bf2f(kk.y >> 16), bf2f(kk.z & 0xffffu), bf2f(kk.z >> 16), bf2f(kk.w & 0xffffu), bf2f(kk.w >> 16)};
                float ss = 0.f;
#pragma unroll
                for (int q = 0; q < 8; ++q) ss += f[q] * f[q];
                ss = sum8(ss);
                const float r = rsqrtf(ss * (1.f / 64.f) + EPS); const float* gp = kg + 8 * ch;
                kk.x = pk2(f[0] * r * gp[0], f[1] * r * gp[1]); kk.y = pk2(f[2] * r * gp[2], f[3] * r * gp[3]); kk.z = pk2(f[4] * r * gp[4], f[5] * r * gp[5]); kk.w = pk2(f[6] * r * gp[6], f[7] * r * gp[7]); }
            *(LAS u32x4*)(lds + j * 128 + ((ch ^ (j & 7)) * 16)) = kk;
            *(LAS u32x4*)(lds + 32768 + j * 128 + ch * 16) = vv; }
        if (un + G < (T / 128) * 2) ATT_LOAD(un + G);
        __syncthreads();
#pragma unroll 1
        for (int task = wave; task < 16; task += 8) {
            const int hq = task & 3, rb = task >> 2, h = kvh * 4 + hq; const int tq = t0 + 32 * rb + r32;
            const float slope2 = exp2f(-(float)(h + 1)) * LOG2E, sink2 = sinks[h] * LOG2E;
            bf16x8 qf[4];
            {
                u32x4 qr[4]; float ss = 0.f;
#pragma unroll
                for (int ds = 0; ds < 4; ++ds) { qr[ds] = *(const u32x4*)(u + (size_t)tq * IND + POOLD + h * 64 + 16 * ds + 8 * hi);
                    const float f[8] = {bf2f(qr[ds].x & 0xffffu), bf2f(qr[ds].x >> 16), bf2f(qr[ds].y & 0xffffu), bf2f(qr[ds].y >> 16), bf2f(qr[ds].z & 0xffffu), bf2f(qr[ds].z >> 16), bf2f(qr[ds].w & 0xffffu), bf2f(qr[ds].w >> 16)};
#pragma unroll
                    for (int q = 0; q < 8; ++q) ss += f[q] * f[q]; }
                ss = xsum32(ss);
                const float r = rsqrtf(ss * (1.f / 64.f) + EPS) * (0.125f * LOG2E);
#pragma unroll
                for (int ds = 0; ds < 4; ++ds) { const float* gp = qg + 16 * ds + 8 * hi;
                    const float f[8] = {bf2f(qr[ds].x & 0xffffu), bf2f(qr[ds].x >> 16), bf2f(qr[ds].y & 0xffffu), bf2f(qr[ds].y >> 16), bf2f(qr[ds].z & 0xffffu), bf2f(qr[ds].z >> 16), bf2f(qr[ds].w & 0xffffu), bf2f(qr[ds].w >> 16)};
                    u32x4 w; w.x = pk2(f[0] * r * gp[0], f[1] * r * gp[1]); w.y = pk2(f[2] * r * gp[2], f[3] * r * gp[3]); w.z = pk2(f[4] * r * gp[4], f[5] * r * gp[5]); w.w = pk2(f[6] * r * gp[6], f[7] * r * gp[7]);
                    qf[ds] = __builtin_bit_cast(bf16x8, w); } }
            f32x16 sc[5];
            const LAS unsigned char* kbase = lds + (32 * rb + r32) * 128;
            int kch[4];
#pragma unroll
            for (int ds = 0; ds < 4; ++ds) kch[ds] = ((2 * ds + hi) ^ (r32 & 7)) * 16;
#pragma unroll
            for (int tt = 0; tt < 5; ++tt) {
#pragma unroll
                for (int r = 0; r < 16; ++r) sc[tt][r] = 0.f;
#pragma unroll
                for (int ds = 0; ds < 4; ++ds) { const bf16x8 kf = *(const LAS bf16x8*)(kbase + kch[ds] + tt * 4096);
                    sc[tt] = __builtin_amdgcn_mfma_f32_32x32x16_bf16(kf, qf[ds], sc[tt], 0, 0, 0); } }
            float mx = -INFINITY;
            int lq = r32 - 4 * hi, lf = 32 * rb + 4 * hi; asm volatile("" : "+v"(lq), "+v"(lf));
            const float lbase = slope2 * (float)(128 + lq);
#pragma unroll
            for (int tt = 0; tt < 5; ++tt)
#pragma unroll
                for (int r = 0; r < 16; ++r) { const int c0 = (r & 3) + 8 * (r >> 2), cc = 32 * tt + c0;
                    float v = fmaf(slope2, (float)cc, sc[tt][r] - lbase);
                    bool ok = true; if (tt == 0) ok = c0 > lq; if (tt == 4) ok = c0 <= lq;
                    if (first && (lf < 128 - cc)) ok = false;
                    v = ok ? v : -INFINITY; sc[tt][r] = v; mx = fmaxf(mx, v); }
            mx = fmaxf(xmax32(mx), sink2);
            float ls = 0.f;
#pragma unroll
            for (int tt = 0; tt < 5; ++tt)
#pragma unroll
                for (int r = 0; r < 16; ++r) { const float p = __builtin_amdgcn_exp2f(sc[tt][r] - mx); sc[tt][r] = p; ls += p; }
            ls = xsum32(ls) + __builtin_amdgcn_exp2f(sink2 - mx);
            const float inv = 1.f / ls;
            f32x16 o[2];
#pragma unroll
            for (int db = 0; db < 2; ++db)
#pragma unroll
                for (int r = 0; r < 16; ++r) o[db][r] = 0.f;
            const int g4 = lane >> 4, i16 = lane & 15;
            const LAS unsigned char* vbase = lds + 32768 + (32 * rb + 4 * (g4 >> 1) + (i16 >> 2)) * 128 + (16 * (g4 & 1) + 4 * (i16 & 3)) * 2;
#pragma unroll
            for (int tt = 0; tt < 5; ++tt)
#pragma unroll
                for (int s2 = 0; s2 < 2; ++s2) {
                    u32x4 pw; pw.x = cvt_pk_bf16(sc[tt][8 * s2 + 0], sc[tt][8 * s2 + 1]); pw.y = cvt_pk_bf16(sc[tt][8 * s2 + 2], sc[tt][8 * s2 + 3]);
                    pw.z = cvt_pk_bf16(sc[tt][8 * s2 + 4], sc[tt][8 * s2 + 5]); pw.w = cvt_pk_bf16(sc[tt][8 * s2 + 6], sc[tt][8 * s2 + 7]);
                    const bf16x8 pb = __builtin_bit_cast(bf16x8, pw);
#pragma unroll
                    for (int db = 0; db < 2; ++db) {
                        const s16x4 lo = __builtin_bit_cast(s16x4, __builtin_amdgcn_ds_read_tr16_b64_v4i16((LAS s16x4*)(vbase + tt * 4096 + s2 * 2048 + db * 64)));
                        const s16x4 hi4 = __builtin_bit_cast(s16x4, __builtin_amdgcn_ds_read_tr16_b64_v4i16((LAS s16x4*)(vbase + tt * 4096 + s2 * 2048 + 1024 + db * 64)));
                        const bf16x8 vf = (bf16x8){lo[0], lo[1], lo[2], lo[3], hi4[0], hi4[1], hi4[2], hi4[3]};
                        o[db] = __builtin_amdgcn_mfma_f32_32x32x16_bf16(vf, pb, o[db], 0, 0, 0); } }
            bf16_t* orow = attn + (size_t)tq * QD + h * 64 + 4 * hi;
#pragma unroll
            for (int db = 0; db < 2; ++db)
#pragma unroll
                for (int gq = 0; gq < 4; ++gq) { u32x2 w; w.x = cvt_pk_bf16(o[db][4 * gq + 0] * inv, o[db][4 * gq + 1] * inv); w.y = cvt_pk_bf16(o[db][4 * gq + 2] * inv, o[db][4 * gq + 3] * inv);
                    *(u32x2*)(orow + 32 * db + 8 * gq) = w; }
        }
        __syncthreads();
    }
#undef ATT_LOAD
}

__global__ void __launch_bounds__(NT, 2) mk_fwd(P a) {
    cg::grid_group grid = cg::this_grid();
    extern __shared__ __attribute__((aligned(16))) unsigned char lds[];
    LAS unsigned char* lds3 = (LAS unsigned char*)lds;
    const int wave_s = __builtin_amdgcn_readfirstlane((int)threadIdx.x >> 6);
    int tid, half, vt, tx, ty, lane, wave; float (*As)[68]; float (*Bs)[64]; size_t gtid;
#define REFRESH() do { tid = wave_s * 64 + lane_id(); asm volatile("" : "+v"(tid)); half = tid >> 8; vt = tid & 255; tx = vt & 15; ty = vt >> 4; lane = tid & 63; wave = tid >> 6; \
        As = (float (*)[68])(lds + half * 8704); Bs = (float (*)[64])(lds + half * 8704 + 4352); gtid = (size_t)blockIdx.x * NT + tid; } while (0)
    REFRESH();
    if (tid < 2) ((volatile LAS unsigned*)(lds3 + LDS_TAB + 1024))[tid] = 0u;
    __syncthreads();
    const XcdBarrier xbar = xcd_barrier_post((unsigned*)(a.ws + C_BAR), (volatile LAS unsigned*)(lds3 + LDS_TAB + 1024), wave_s == 0);
    const int G = gridDim.x; const size_t gthreads = (size_t)G * NT; const int nwaves = G * (NT / 64);
#define Wcat ((bf16_t*)(a.ws + W_CAT))
#define Wpp ((bf16_t*)(a.ws + W_PP))
#define Wmix ((bf16_t*)(a.ws + W_MIX))
#define Wa_ ((bf16_t*)(a.ws + W_A))
#define Wb_ ((bf16_t*)(a.ws + W_B))
#define Wout ((bf16_t*)(a.ws + W_OUT))
#define Wsh ((bf16_t*)(a.ws + W_SH))
#define Wr ((bf16_t*)(a.ws + W_R))
#define Wsd ((bf16_t*)(a.ws + W_SD))
#define Wpg ((bf16_t*)(a.ws + W_PG))
#define Wexp ((bf16_t*)(a.ws + W_EXP))
#define Wed ((bf16_t*)(a.ws + W_ED))
#define rsspp ((float*)(a.ws + C_RSPP))
#define rss2 ((float*)(a.ws + C_RS2))
#define rss3 ((float*)(a.ws + C_RS3))
#define cntblk ((int*)(a.ws + C_CNTBLK))
#define sel ((int*)(a.ws + C_SEL))
#define tokl ((int*)(a.ws + C_TOKL))
#define rinfo ((int2*)(a.ws + C_RINFO))
#define wl ((float*)(a.ws + LOGITS))
#define Yb ((unsigned char*)(a.ws + YB))
#define wts ((float*)(a.ws + C_WTS))
#define ppb ((bf16_t*)(a.ws + PP))
#define hb ((bf16_t*)(a.ws + HB))
#define pb ((bf16_t*)(a.ws + PB))
#define ub ((bf16_t*)(a.ws + UB))
#define gb ((bf16_t*)(a.ws + GB))
#define poolb ((bf16_t*)(a.ws + POOLB))
#define logits ((float*)(a.ws + LOGITS))
#define attnb ((bf16_t*)(a.ws + HB))
#define mixb ((bf16_t*)(a.ws + HB + 32 * MiB))
#define mergedb ((bf16_t*)(a.ws + UB))
#define hg2 ((bf16_t*)(out))
#define hg3 ((bf16_t*)(a.ws + W_EXP))
#define actsh ((bf16_t*)(a.ws + ACTSH))
#define actr ((bf16_t*)(a.ws + ACTR))
#define out (a.out)
    {
        LAS float* scr = (LAS float*)(lds3 + wave * 16384);
        const int gw = blockIdx.x * (NT / 64) + wave;
        constexpr int I_IN = 16 * 40, I_G = 16 * 64, I_PP = 4 * 32, I_AB = 8 * 32, I_SQ = 16 * 32, I_GU = 16 * 8, I_R = 16 * 2, I_SD = 4 * 32;
        constexpr int I_E = NE * 128;
        constexpr int NITEMS = I_IN + I_G + I_PP + 2 * I_AB + 2 * I_SQ + 2 * I_GU + I_R + I_SD + 3 * I_E;
        auto decode = [&](int it) -> TItem { int r = it;
            if (r < I_IN) return ti_plain(a.w_in, D, IND, Wcat, 0, r); r -= I_IN;
            if (r < I_G) return ti_gate(a.w_gate, Wcat, r); r -= I_G;
            if (r < I_PP) return ti_plain(a.w_pp, PLE, D, Wpp, 0, r); r -= I_PP;
            if (r < I_AB) return ti_plain(a.w_a, 512, D, Wa_, 0, r); r -= I_AB;
            if (r < I_AB) return ti_plain(a.w_b, 512, D, Wb_, 0, r); r -= I_AB;
            if (r < I_SQ) return ti_plain(a.w_out, D, D, Wout, 0, r); r -= I_SQ;
            if (r < I_SQ) return ti_plain(a.w_pg, D, D, Wpg, 0, r, a.g_ple); r -= I_SQ;
            if (r < I_GU) return ti_gu(a.w_sg, Wsh, 0, r, a.g_ffn); r -= I_GU;
            if (r < I_GU) return ti_gu(a.w_su, Wsh, 1, r, a.g_ffn); r -= I_GU;
            if (r < I_R) return ti_plain(a.w_router, D, NE, Wr, 0, r, a.g_ffn); r -= I_R;
            if (r < I_SD) return ti_plain(a.w_sd, SD, D, Wsd, 0, r); r -= I_SD;
            if (r < I_E) { const int e = r >> 7; return ti_gu(a.w_eg + (size_t)e * D * ED, Wexp + (size_t)e * 512 * D, 0, r & 127, a.g_ffn); } r -= I_E;
            if (r < I_E) { const int e = r >> 7; return ti_gu(a.w_eu + (size_t)e * D * ED, Wexp + (size_t)e * 512 * D, 1, r & 127, a.g_ffn); } r -= I_E;
            { const int e = r >> 7; return ti_plain(a.w_ed + (size_t)e * ED * D, ED, D, Wed + (size_t)e * D * ED, 0, r & 127); } };
        if (gw < NITEMS) {
            TItem cur_ = decode(gw); f32x4 va[8], vb[8]; ti_load(cur_, va, lane);
            for (int it = gw; it < NITEMS; it += 2 * nwaves) {
                const int i1 = it + nwaves, i2 = it + 2 * nwaves; TItem n1 = cur_, n2 = cur_;
                if (i1 < NITEMS) { n1 = decode(i1); ti_load(n1, vb, lane); }
                ti_finish(cur_, va, scr, lane);
                if (i1 < NITEMS) { if (i2 < NITEMS) { n2 = decode(i2); ti_load(n2, va, lane); } ti_finish(n1, vb, scr, lane); cur_ = n2; }
            }
        }
        for (size_t i = gtid; i < (size_t)2 * 256 * 256; i += gthreads) { const int pn = (int)(i >> 16), n = (int)((i >> 8) & 255), k = (int)(i & 255);
            const float v = ((n >> 7) == (k >> 7)) ? a.w_pool_mix[(size_t)(2 * pn + (n >> 7)) * 128 * 128 + (size_t)(k & 127) * 128 + (n & 127)] * a.pool_scale[256 * pn + n] : 0.f;
            Wmix[i] = (bf16_t)f2bf(v); }
        for (size_t i = gtid; i < (size_t)192 * D / 8; i += gthreads) *((u32x4*)(Wr + (size_t)64 * D) + i) = (u32x4){0u, 0u, 0u, 0u};
        for (int m0 = gw; m0 < T; m0 += 2 * nwaves) {
            f32x4 v[2][4], pv[2]; float sq[2];
#pragma unroll
            for (int rr = 0; rr < 2; ++rr) { const int m = (m0 + rr * nwaves < T) ? m0 + rr * nwaves : m0; const f32x4* xr = (const f32x4*)(a.x + (size_t)m * D) + lane;
#pragma unroll
                for (int j = 0; j < 4; ++j) v[rr][j] = xr[64 * j];
                pv[rr] = *((const f32x4*)(a.p + (size_t)m * PLE) + lane); }
#pragma unroll
            for (int rr = 0; rr < 2; ++rr) { float s_ = 0.f;
#pragma unroll
                for (int j = 0; j < 4; ++j) s_ += (v[rr][j].x * v[rr][j].x + v[rr][j].y * v[rr][j].y) + (v[rr][j].z * v[rr][j].z + v[rr][j].w * v[rr][j].w);
                sq[rr] = wave_sum(s_); }
#pragma unroll
            for (int rr = 0; rr < 2; ++rr) { const int m = m0 + rr * nwaves; if (m < T) { const float r = rsqrtf(sq[rr] * (1.f / D) + EPS);
                u32x2* o8 = (u32x2*)(hb + (size_t)m * D) + lane;
#pragma unroll
                for (int j = 0; j < 4; ++j) { const f32x4 gg = *((const f32x4*)a.g_mix + lane + 64 * j); u32x2 w; w.x = pk2(v[rr][j].x * r * gg.x, v[rr][j].y * r * gg.y); w.y = pk2(v[rr][j].z * r * gg.z, v[rr][j].w * r * gg.w); o8[64 * j] = w; }
                u32x2 w; w.x = pk2(pv[rr].x, pv[rr].y); w.y = pk2(pv[rr].z, pv[rr].w); *((u32x2*)(pb + (size_t)m * PLE) + lane) = w; } }
        }
        for (size_t i = gtid; i < (size_t)T; i += gthreads) { rsspp[i] = 0.f; rss2[i] = 0.f; rss3[i] = 0.f; }
    }
    if (gridDim.x == 0x7fffffffu) grid.sync();
    xcd_barrier(xbar, tid); REFRESH();
    {
        pg8::Cfg g1{(unsigned)D * 2u, (unsigned)D * 2u, D};
        pg8::DenseSched S1{T / 256, NCAT / 256, G, (int)blockIdx.x, (const char*)hb, (const char*)Wcat, (size_t)256 * D * 2, (size_t)256 * D * 2};
        EpiG1 E1{ub, gb, a.b_gate};
        pg8::gemm_phase<EpiG1, pg8::DenseSched, false>(lds3, g1, S1, E1, wave_s);
        pg8::Cfg g2{(unsigned)PLE * 2u, (unsigned)PLE * 2u, PLE};
        PPSched S2{G, (int)blockIdx.x, (const char*)pb, (const char*)Wpp};
        EpiPP E2{ppb, rsspp};
        pg8::gemm_phase<EpiPP, PPSched, false>(lds3, g2, S2, E2, wave_s);
    }
    xcd_barrier(xbar, tid); REFRESH();
    for (int i = 0;; ++i) { int pm, pn; if (!pg8::static_tile(i, G, (int)blockIdx.x, T / 256, 2, pm, pn)) break;
        const int ch = tid & 31, rg = tid >> 5, col = 256 * pn + 8 * ch, w = 2 << (col >> 7), t0 = 256 * pm + 16 * rg, pos0 = t0 % SEQ;
        const bf16_t* rp0 = ub + (size_t)t0 * IND + col; float sw[8];
#pragma unroll
        for (int q = 0; q < 8; ++q) sw[q] = 0.f;
        { u32x4 pv[15];
#pragma unroll
          for (int k = 1; k < 16; ++k) pv[k - 1] = *(const u32x4*)(rp0 - (size_t)((k < w && k <= pos0) ? k : 0) * IND);
#pragma unroll
          for (int k = 1; k < 16; ++k) { const float mk = (k < w && k <= pos0) ? 1.f : 0.f; const u32x4 p4 = pv[k - 1];
              sw[0] += mk * bf2f(p4.x & 0xffffu); sw[1] += mk * bf2f(p4.x >> 16); sw[2] += mk * bf2f(p4.y & 0xffffu); sw[3] += mk * bf2f(p4.y >> 16);
              sw[4] += mk * bf2f(p4.z & 0xffffu); sw[5] += mk * bf2f(p4.z >> 16); sw[6] += mk * bf2f(p4.w & 0xffffu); sw[7] += mk * bf2f(p4.w >> 16); } }
#pragma unroll 1
        for (int b4 = 0; b4 < 4; ++b4) { u32x4 nw[4], od[4];
#pragma unroll
            for (int j = 0; j < 4; ++j) { const int r = 4 * b4 + j; nw[j] = *(const u32x4*)(rp0 + (size_t)r * IND);
                od[j] = *(const u32x4*)(rp0 + (size_t)((pos0 + r >= w - 1) ? r - (w - 1) : r) * IND); }
#pragma unroll
            for (int j = 0; j < 4; ++j) { const int r = 4 * b4 + j; const int cn = pos0 + r + 1 < w ? pos0 + r + 1 : w; const float ic = 1.f / (float)cn, mo = (pos0 + r >= w - 1) ? 1.f : 0.f;
                const float c8[8] = {bf2f(nw[j].x & 0xffffu), bf2f(nw[j].x >> 16), bf2f(nw[j].y & 0xffffu), bf2f(nw[j].y >> 16), bf2f(nw[j].z & 0xffffu), bf2f(nw[j].z >> 16), bf2f(nw[j].w & 0xffffu), bf2f(nw[j].w >> 16)};
                const float o8[8] = {bf2f(od[j].x & 0xffffu), bf2f(od[j].x >> 16), bf2f(od[j].y & 0xffffu), bf2f(od[j].y >> 16), bf2f(od[j].z & 0xffffu), bf2f(od[j].z >> 16), bf2f(od[j].w & 0xffffu), bf2f(od[j].w >> 16)};
                float e8[8];
#pragma unroll
                for (int q = 0; q < 8; ++q) { sw[q] += c8[q]; e8[q] = sw[q] * ic - c8[q]; sw[q] -= mo * o8[q]; }
                u32x4 o; o.x = pk2(e8[0], e8[1]); o.y = pk2(e8[2], e8[3]); o.z = pk2(e8[4], e8[5]); o.w = pk2(e8[6], e8[7]);
                *(u32x4*)(poolb + (size_t)(t0 + r) * POOLD + col) = o; } } }
    asm volatile("s_waitcnt vmcnt(0)" ::: "memory");
    __syncthreads();
    {
        pg8::Cfg gm{(unsigned)POOLD * 2u, 512u, 256};
        MixSched Sm{G, (int)blockIdx.x, (const char*)poolb, (const char*)Wmix};
        EpiBf16Plain Em{mixb, POOLD};
        pg8::gemm_phase<EpiBf16Plain, MixSched, false>(lds3, gm, Sm, Em, wave_s);
    }
    REFRESH();
    attn_phase(lds3, ub, attnb, a.sinks, a.q_gain, a.k_gain, G, wave_s);
    xcd_barrier(xbar, tid); REFRESH();
    {
        pg8::Cfg g4{1024u, 1024u, 512};
        MergedSched S4{G, (int)blockIdx.x, (const char*)mixb, (const char*)attnb, (const char*)Wa_, (const char*)Wb_};
        EpiMerged E4{gb, mergedb};
        pg8::gemm_phase<EpiMerged, MergedSched, false>(lds3, g4, S4, E4, wave_s);
    }
    xcd_barrier(xbar, tid); REFRESH();
    {
        pg8::Cfg g5{(unsigned)D * 2u, (unsigned)D * 2u, D};
        pg8::DenseSched S5{T / 256, D / 256, G, (int)blockIdx.x, (const char*)mergedb, (const char*)Wout, (size_t)256 * D * 2, (size_t)256 * D * 2};
        EpiResid E5{a.x, hg2, rss2};
        pg8::gemm_phase<EpiResid, pg8::DenseSched, false>(lds3, g5, S5, E5, wave_s);
    }
    xcd_barrier(xbar, tid); REFRESH();
    {
        pg8::Cfg g6{(unsigned)D * 2u, (unsigned)D * 2u, D};
        P6Sched S6{G, (int)blockIdx.x, (const char*)hg2, (const char*)Wsh};
        EpiShared E6{actsh, logits, rss2};
        pg8::gemm_phase<EpiShared, P6Sched, false>(lds3, g6, S6, E6, wave_s);
    }
    REFRESH();
    if (G != 256) { xcd_barrier(xbar, tid); REFRESH(); }
    __syncthreads();
    for (int cpair = blockIdx.x; cpair < NCHUNK / 2; cpair += G) {
        float (*C)[65] = (float (*)[65])(lds + (wave & 3) * 16640);
        int* cw = (int*)(lds + 4 * 16640);
        const int ch = cpair * 2 + ((wave >> 1) & 1);
        int idx[8], rk[8]; float sv[8]; const int t = ch * 128 + (wave & 1) * 64 + lane;
        if (wave < 4) {
            { const f32x4* lg4 = (const f32x4*)(logits + (size_t)(t - lane) * 64); const f32x4 b4 = *((const f32x4*)a.router_bias + (lane & 15)); f32x4 lv[16];
#pragma unroll
              for (int i = 0; i < 16; ++i) lv[i] = lg4[i * 64 + lane];
#pragma unroll
              for (int i = 0; i < 16; ++i) { float* cr = &C[4 * i + (lane >> 4)][4 * (lane & 15)];
#pragma unroll
                  for (int q = 0; q < 4; ++q) cr[q] = 1.f / (1.f + expf(-lv[i][q])) + b4[q]; } }
            float gs[8];
#pragma unroll
            for (int g = 0; g < 8; ++g) { float m1 = -INFINITY, m2 = -INFINITY;
#pragma unroll
                for (int j = 0; j < 8; ++j) { const float v = C[lane][g * 8 + j]; if (v > m1) { m2 = m1; m1 = v; } else if (v > m2) m2 = v; }
                gs[g] = m1 + m2; }
            unsigned gsel = 0u;
#pragma unroll
            for (int it = 0; it < 4; ++it) { float best = -INFINITY; int bi = 0;
#pragma unroll
                for (int g = 0; g < 8; ++g) { const bool fr_ = !((gsel >> g) & 1u); if (fr_ && gs[g] > best) { best = gs[g]; bi = g; } }
                gsel |= 1u << bi; }
            unsigned long long chosen = 0ull; float wsum = 0.f;
#pragma unroll
            for (int g = 0; g < 8; ++g) if (!((gsel >> g) & 1u)) {
#pragma unroll
                for (int j = 0; j < 8; ++j) C[lane][g * 8 + j] = -INFINITY; }
#pragma unroll
            for (int k = 0; k < 8; ++k) { float best = -INFINITY; int bi = 0;
#pragma unroll 8
                for (int e = 0; e < 64; ++e) { const float v = C[lane][e]; if (v > best) { best = v; bi = e; } }
                C[lane][bi] = -INFINITY; chosen |= 1ull << bi; idx[k] = bi; sv[k] = 1.f / (1.f + expf(-logits[(size_t)t * 64 + bi])); wsum += sv[k]; rk[k] = 0; }
#pragma unroll
            for (int k = 0; k < 8; ++k) sv[k] = sv[k] / (wsum + 1e-20f) * 2.5f;
#pragma unroll 1
            for (int e = 0; e < 64; ++e) { const bool chs = (chosen >> e) & 1ull; const unsigned long long mm = __ballot(chs); const int r = __popcll(mm & ((1ull << lane) - 1ull));
                if (lane == 0) cw[wave * 64 + e] = __popcll(mm);
#pragma unroll
                for (int k = 0; k < 8; ++k) if (idx[k] == e) rk[k] = r; }
        }
        __syncthreads();
        if (wave < 4) {
#pragma unroll
            for (int k = 0; k < 8; ++k) { const int r = rk[k] + ((wave & 1) ? cw[(wave - 1) * 64 + idx[k]] : 0); sel[(size_t)t * 8 + k] = idx[k] | (r << 8); wts[(size_t)t * 8 + k] = sv[k]; }
            if ((wave & 1) == 0) cntblk[ch * 64 + lane] = cw[wave * 64 + lane] + cw[(wave + 1) * 64 + lane];
        }
        __syncthreads();
    }
    xcd_barrier(xbar, tid); REFRESH();
    {
        int* tot = (int*)(lds + 0); int* pst = (int*)(lds + 512); int* base = (int*)(lds + 1024); LAS int* mts = (LAS int*)(lds3 + LDS_TAB);
        int* part = (int*)(lds + 2048);
        LAS int* lo_t = (LAS int*)(lds3 + LDS_TAB + LT_LO); LAS int* tst_t = (LAS int*)(lds3 + LDS_TAB + LT_TST);
        LAS unsigned char* t2e7 = lds3 + LDS_TAB + LT_T2E7; LAS unsigned char* t2e8 = lds3 + LDS_TAB + LT_T2E8;
        const int e_ = tid & 63, pt = tid >> 6; const int ch0 = blockIdx.x;
        { int sr[NROUND + 1];
#pragma unroll
          for (int r = 0; r <= NROUND; ++r) sr[r] = 0;
#pragma unroll 4
          for (int c2 = pt; c2 < NCHUNK; c2 += 8) { const int v = cntblk[c2 * 64 + e_]; sr[0] += v; sr[NROUND] += (c2 < ch0) ? v : 0;
#pragma unroll
              for (int r = 1; r < NROUND; ++r) sr[r] += (c2 < r * (NCHUNK / NROUND)) ? v : 0; }
#pragma unroll
          for (int r = 0; r <= NROUND; ++r) part[r * 512 + pt * 64 + e_] = sr[r]; }
        __syncthreads();
        if (tid < 64) {
#pragma unroll
            for (int r = 0; r <= NROUND; ++r) { int sm = 0;
#pragma unroll
                for (int q = 0; q < 8; ++q) sm += part[r * 512 + q * 64 + tid];
                if (r == 0) tot[tid] = sm; else if (r == NROUND) base[tid] = sm; else lo_t[r * 64 + tid] = sm; } }
        __syncthreads();
        if (tid == 0) { int p = 0, m = 0; for (int e = 0; e < 64; ++e) { pst[e] = p; mts[e] = m; const int pd = (tot[e] + 255) & ~255; p += pd; m += pd >> 8; } pst[64] = p; mts[64] = m; mts[65] = m; }
        __syncthreads();
        if (tid < 64) { const int p0 = pst[tid]; lo_t[tid] = p0;
#pragma unroll
            for (int r = 1; r < NROUND; ++r) lo_t[r * 64 + tid] += p0;
            lo_t[NROUND * 64 + tid] = p0 + tot[tid];
            for (int j = mts[tid]; j < mts[tid + 1]; ++j) t2e7[j] = (unsigned char)tid; }
        __syncthreads();
        if (tid < NROUND) { LAS int* cb_t = (LAS int*)(lds3 + LDS_TAB + LT_CB); int m = 0, cacc = 0; for (int e = 0; e < 64; ++e) { tst_t[tid * 65 + e] = m; cb_t[tid * 64 + e] = cacc; cacc += lo_t[(tid + 1) * 64 + e] - lo_t[tid * 64 + e]; const int nt_ = (lo_t[(tid + 1) * 64 + e] - lo_t[tid * 64 + e] + 255) >> 8;
                for (int j = 0; j < nt_; ++j) t2e8[tid * T2S + (m + j)] = (unsigned char)e; m += nt_; } tst_t[tid * 65 + 64] = m; }
        __syncthreads();
        if ((int)blockIdx.x < 64 && tid < 256) { const int e = blockIdx.x; const int j = tot[e] + tid; if (j < ((tot[e] + 255) & ~255)) { tokl[pst[e] + j] = -1; rinfo[pst[e] + j] = make_int2(-1, 0); wl[pst[e] + j] = 0.f; } }
        for (int ch = blockIdx.x; ch < NCHUNK; ch += G) {
            if (ch != ch0) {
                __syncthreads();
                if (tid < 64) { int sum = 0;
#pragma unroll 4
                    for (int c2 = 0; c2 < ch; ++c2) sum += cntblk[c2 * 64 + tid];
                    base[tid] = sum; }
                __syncthreads();
            }
            if (tid < 128) { const int t = ch * 128 + tid;
#pragma unroll
                for (int k = 0; k < 8; ++k) { const int sl = sel[(size_t)t * 8 + k]; const int e_k = sl & 255, pos = pst[e_k] + base[e_k] + (sl >> 8), rr_ = t / TR;
                    sel[(size_t)t * 8 + k] = ((const LAS int*)(lds3 + LDS_TAB + LT_CB))[rr_ * 64 + e_k] + (pos - lo_t[rr_ * 64 + e_k]);
                    tokl[pos] = t * 8 + k; rinfo[pos] = make_int2(t * 9 + k, __float_as_int(rsqrtf(rss2[t] * (1.f / D) + EPS))); wl[pos] = wts[(size_t)t * 8 + k]; } }
        }
    }
    xcd_barrier(xbar, tid); REFRESH();
    const int ntr = ((LAS int*)(lds3 + LDS_TAB))[64];
    {
        pg8::Cfg g7{(unsigned)D * 2u, (unsigned)D * 2u, D};
        RoutedUpSched S7{G, (int)blockIdx.x, ntr, (const LAS unsigned char*)(lds3 + LDS_TAB + LT_T2E7), tokl, (const char*)hg2, (const char*)Wexp};
        EpiRoutedUp E7{actr, rinfo, wl};
        pg8::gemm_phase<EpiRoutedUp, RoutedUpSched, true>(lds3, g7, S7, E7, wave_s);
    }
    xcd_barrier(xbar, tid); REFRESH();
#pragma unroll 1
    for (int q = 0; q <= NROUND; ++q) {
#pragma unroll 1
        for (int part2 = 0; part2 < 2; ++part2) {
            const bool do_down = (part2 == (int)(blockIdx.x & 1));
            if (do_down) { if (q < NROUND) {
                pg8::Cfg g8{(unsigned)ED * 2u, (unsigned)ED * 2u, ED};
                DownSched S8{G, (int)blockIdx.x, q, (const LAS int*)(lds3 + LDS_TAB + LT_LO), (const LAS int*)(lds3 + LDS_TAB + LT_TST), (const LAS unsigned char*)(lds3 + LDS_TAB + LT_T2E8), (const LAS int*)(lds3 + LDS_TAB + LT_CB), (const char*)actr, (const char*)actsh, (const char*)Wed, (const char*)Wsd};
                EpiDown E8{Yb + (size_t)(q & 1) * TR * 9 * 1024};
                pg8::gemm_phase<EpiDown, DownSched, false>(lds3, g8, S8, E8, wave_s);
                REFRESH(); }
            } else if (q > 0) { const int qc = q - 1;
                char* wsl = a.ws; float* outl = out; asm volatile("" : "+s"(wsl), "+s"(outl));
                const unsigned char* Yc = (const unsigned char*)(wsl + YB) + (size_t)(qc & 1) * TR * 9 * 1024; const int* sel_l = (const int*)(wsl + C_SEL); const bf16_t* x1l = (const bf16_t*)outl; bf16_t* x2l = (bf16_t*)(wsl + W_EXP); float* rss3l = (float*)(wsl + C_RS3);
                int rem = 0; if (q < NROUND) rem = ((((const LAS int*)(lds3 + LDS_TAB + LT_TST))[q * 65 + 64] + TR / 256) * 4) % G;
                if (rem > G / 2) rem = 0;
                const int li = (int)blockIdx.x - rem, nlw = (G - rem) * (NT / 64);
                if (li >= 0)
                for (int tl0 = li * (NT / 64) + wave; tl0 < TR; tl0 += 2 * nlw) { const int nwaves_c = nlw; const int col = lane * 16;
                    u32x4 y[2][9], xa[2], xb_[2];
#pragma unroll
                    for (int u2 = 0; u2 < 2; ++u2) { const int tl_ = (tl0 + u2 * nwaves_c < TR) ? tl0 + u2 * nwaves_c : tl0; const int t = qc * TR + tl_;
                        const bf16_t* xi = x1l + (size_t)t * D + col;
#pragma unroll
                        for (int k = 0; k < 8; ++k) y[u2][k] = *(const u32x4*)(Yc + (size_t)sel_l[(size_t)t * 8 + k] * 1024 + col);
                        y[u2][8] = *(const u32x4*)(Yc + (size_t)(8 * TR + tl_) * 1024 + col);
                        xa[u2] = *(const u32x4*)xi; xb_[u2] = *(const u32x4*)(xi + 8); }
#pragma unroll
                    for (int u2 = 0; u2 < 2; ++u2) { const int tl_ = tl0 + u2 * nwaves_c; if (tl_ < TR) { const int t = qc * TR + tl_;
                        f32x4 v[4];
                        v[0] = (f32x4){bf2f(xa[u2].x & 0xffffu), bf2f(xa[u2].x >> 16), bf2f(xa[u2].y & 0xffffu), bf2f(xa[u2].y >> 16)}; v[1] = (f32x4){bf2f(xa[u2].z & 0xffffu), bf2f(xa[u2].z >> 16), bf2f(xa[u2].w & 0xffffu), bf2f(xa[u2].w >> 16)};
                        v[2] = (f32x4){bf2f(xb_[u2].x & 0xffffu), bf2f(xb_[u2].x >> 16), bf2f(xb_[u2].y & 0xffffu), bf2f(xb_[u2].y >> 16)}; v[3] = (f32x4){bf2f(xb_[u2].z & 0xffffu), bf2f(xb_[u2].z >> 16), bf2f(xb_[u2].w & 0xffffu), bf2f(xb_[u2].w >> 16)};
#pragma unroll
                        for (int k = 0; k < 9; ++k)
#pragma unroll
                            for (int j = 0; j < 4; ++j) { const f32x2 lo2 = __builtin_amdgcn_cvt_pk_f32_fp8((int)y[u2][k][j], false), hi2 = __builtin_amdgcn_cvt_pk_f32_fp8((int)y[u2][k][j], true);
                                v[j][0] += lo2.x; v[j][1] += lo2.y; v[j][2] += hi2.x; v[j][3] += hi2.y; }
                        float ss = 0.f; u32x4 w0, w1;
#pragma unroll
                        for (int j = 0; j < 4; ++j) { const unsigned p0 = pk2(v[j][0], v[j][1]), p1 = pk2(v[j][2], v[j][3]);
                            if (j == 0) { w0.x = p0; w0.y = p1; } else if (j == 1) { w0.z = p0; w0.w = p1; } else if (j == 2) { w1.x = p0; w1.y = p1; } else { w1.z = p0; w1.w = p1; }
                            ss += (v[j][0] * v[j][0] + v[j][1] * v[j][1]) + (v[j][2] * v[j][2] + v[j][3] * v[j][3]); }
                        *(u32x4*)(x2l + (size_t)t * D + col) = w0; *(u32x4*)(x2l + (size_t)t * D + col + 8) = w1;
                        ss = wave_sum(ss);
                        if (lane == 0) rss3l[t] = ss; } }
                }
            }
        }
        xcd_barrier(xbar, tid); REFRESH();
    }
    {
        pg8::Cfg g9{(unsigned)D * 2u, (unsigned)D * 2u, D};
        pg8::DenseSched S9{T / 256, D / 256, G, (int)blockIdx.x, (const char*)hg3, (const char*)Wpg, (size_t)256 * D * 2, (size_t)256 * D * 2};
        EpiFinal E9{out, hg3, ppb, rss3, rsspp, a.g_post};
        pg8::gemm_phase<EpiFinal, pg8::DenseSched, false>(lds3, g9, S9, E9, wave_s);
    }
}
#undef Wcat
#undef Wpp
#undef Wmix
#undef Wa_
#undef Wb_
#undef Wout
#undef Wsh
#undef Wr
#undef Wsd
#undef Wpg
#undef Wexp
#undef Wed
#undef rsspp
#undef rss2
#undef rss3
#undef cntblk
#undef sel
#undef tokl
#undef rinfo
#undef wl
#undef Yb
#undef wts
#undef ppb
#undef hb
#undef pb
#undef ub
#undef gb
#undef poolb
#undef logits
#undef attnb
#undef mixb
#undef mergedb
#undef hg2
#undef hg3
#undef actsh
#undef actr
#undef out
}

extern "C" void kernel_launch(void* const* d_in, const int* in_sizes, int n_in, void* d_out, int out_size, void* d_ws, size_t ws_size, hipStream_t stream) {
    using namespace mk;
    static int grid_blocks = 0;
    constexpr size_t LDSB = 147456;
    if (!grid_blocks) {
        int dev = 0, cus = 0, per_cu = 0;
        (void)hipGetDevice(&dev); (void)hipDeviceGetAttribute(&cus, hipDeviceAttributeMultiprocessorCount, dev);
        (void)hipFuncSetAttribute((const void*)mk_fwd, hipFuncAttributeMaxDynamicSharedMemorySize, (int)LDSB);
        (void)hipOccupancyMaxActiveBlocksPerMultiprocessor(&per_cu, (const void*)mk_fwd, NT, LDSB);
        if (per_cu < 1) { fprintf(stderr, "occupancy query says %d blocks per CU\n", per_cu); }
        grid_blocks = cus;
    }
    if (ws_size < (size_t)512 * MiB) { fprintf(stderr, "ws too small: %zu\n", ws_size); return; }
    P a{};
    a.x = (const float*)d_in[0]; a.p = (const float*)d_in[1]; a.g_mix = (const float*)d_in[2]; a.w_in = (const float*)d_in[3]; a.w_pool_mix = (const float*)d_in[4];
    a.pool_scale = (const float*)d_in[5]; a.w_a = (const float*)d_in[6]; a.q_gain = (const float*)d_in[7]; a.k_gain = (const float*)d_in[8]; a.sinks = (const float*)d_in[9];
    a.w_b = (const float*)d_in[10]; a.w_gate = (const float*)d_in[11]; a.b_gate = (const float*)d_in[12]; a.w_out = (const float*)d_in[13]; a.g_ffn = (const float*)d_in[14];
    a.w_router = (const float*)d_in[15]; a.router_bias = (const float*)d_in[16]; a.w_eg = (const float*)d_in[17]; a.w_eu = (const float*)d_in[18]; a.w_ed = (const float*)d_in[19];
    a.w_sg = (const float*)d_in[20]; a.w_su = (const float*)d_in[21]; a.w_sd = (const float*)d_in[22]; a.g_ple = (const float*)d_in[23]; a.w_pg = (const float*)d_in[24];
    a.w_pp = (const float*)d_in[25]; a.g_post = (const float*)d_in[26]; a.out = (float*)d_out; a.ws = (char*)d_ws;
    (void)hipMemsetAsync((char*)d_ws + C_BAR, 0, 16384, stream);
    void* args[] = {&a};
    hipError_t e = hipLaunchCooperativeKernel((const void*)mk_fwd, dim3(grid_blocks), dim3(NT), args, LDSB, stream);
    if (e != hipSuccess) fprintf(stderr, "cooperative launch failed: %s (grid %d)\n", hipGetErrorString(e), grid_blocks);
}
```

```cpp
#include <hip/hip_runtime.h>
#include <hip/hip_cooperative_groups.h>
#include <cstdio>
#include <cstdint>
namespace cg = cooperative_groups;

#define LAS __attribute__((address_space(3)))
typedef unsigned short bf16_t;
typedef short bf16x8 __attribute__((ext_vector_type(8)));
typedef float f32x4 __attribute__((ext_vector_type(4)));
typedef unsigned u32x4 __attribute__((ext_vector_type(4)));
typedef unsigned u32x2 __attribute__((ext_vector_type(2)));
typedef float f32x2 __attribute__((ext_vector_type(2)));

namespace mk {
constexpr int T = 32768, D = 1024, SEQ = 4096, PLE = 256;
constexpr int POOLD = 512, QD = 512, KVD = 128, IND = 1280, NCAT = 3328;
constexpr int NE = 64, ED = 256, SD = 256;
constexpr float EPS = 1e-6f;
constexpr float LOG2E = 1.4426950408889634f;
constexpr int NT = 512;
constexpr size_t MiB = 1u << 20;
constexpr size_t W_CAT = 0;
constexpr size_t W_PP = W_CAT + (size_t)NCAT * D * 2;
constexpr size_t W_MIX = W_PP + (size_t)D * PLE * 2;
constexpr size_t W_A = W_MIX + 2 * 256 * 256 * 2;
constexpr size_t W_B = W_A + (size_t)D * 512 * 2;
constexpr size_t W_OUT = W_B + (size_t)D * 512 * 2;
constexpr size_t W_SH = W_OUT + (size_t)D * D * 2;
constexpr size_t W_R = W_SH + (size_t)512 * D * 2;
constexpr size_t W_SD = W_R + (size_t)256 * D * 2;
constexpr size_t W_PG = W_SD + (size_t)D * 256 * 2;
constexpr size_t W_EXP = 16 * MiB;
constexpr size_t W_ED = 80 * MiB;
static_assert(W_PG + (size_t)D * D * 2 <= W_EXP, "weights map");
constexpr size_t CTL = 112 * MiB;
constexpr size_t C_RSPP = CTL, C_RS2 = CTL + 128 * 1024, C_RS3 = CTL + 256 * 1024;
constexpr size_t C_CNTBLK = CTL + 512 * 1024;
constexpr size_t C_SEL = CTL + 2 * MiB;
constexpr size_t C_TOKL = CTL + 3 * MiB;
constexpr size_t C_RINFO = CTL + 4 * MiB + 512 * 1024;
constexpr size_t YB = 184 * MiB;
constexpr size_t ACTSH = 464 * MiB;
constexpr int NCHUNK = T / 128;
constexpr size_t C_BAR = CTL + 7 * MiB + 512 * 1024;
constexpr int NROUND = 4, TR = T / NROUND;
constexpr int LT_LO = 4096, LT_TST = LT_LO + (NROUND + 1) * 64 * 4, LT_T2E7 = LT_TST + NROUND * 65 * 4, LT_T2E8 = LT_T2E7 + 1152;
constexpr int T2S = TR * 8 / 256 + 64;
constexpr int LT_CB = LT_T2E8 + NROUND * T2S;
static_assert(LT_CB % 4 == 0 && LT_CB + NROUND * 64 * 4 <= 16384 && TR / 128 * NROUND == T / 128, "LDS tables");
constexpr int LDS_TAB = 131072;
constexpr size_t C_WTS = CTL + 1 * MiB;
constexpr size_t PP = 120 * MiB;
constexpr size_t HB = 184 * MiB;
constexpr size_t PB = 248 * MiB;
constexpr size_t UB = 264 * MiB;
constexpr size_t GB = 344 * MiB;
constexpr size_t POOLB = 472 * MiB;
constexpr size_t LOGITS = 504 * MiB;
constexpr size_t ACTR = 328 * MiB;

__device__ __forceinline__ int lane_id() { int l; asm volatile("v_mbcnt_lo_u32_b32 %0, -1, 0\n\tv_mbcnt_hi_u32_b32 %0, -1, %0" : "=v"(l)); return l; }
__device__ __forceinline__ float bf2f(unsigned v) { return __uint_as_float(v << 16); }
__device__ __forceinline__ unsigned f2bf(float f) { unsigned u = __float_as_uint(f); return (u + 0x7fffu + ((u >> 16) & 1u)) >> 16; }
__device__ __forceinline__ unsigned cvt_pk_bf16(float lo, float hi) { unsigned r; asm volatile("v_cvt_pk_bf16_f32 %0, %1, %2" : "=v"(r) : "v"(lo), "v"(hi)); return r; }
__device__ __forceinline__ unsigned pk2(float lo, float hi) { return f2bf(lo) | (f2bf(hi) << 16); }
__device__ __forceinline__ float dpp_f(float v, int ctrl_sel) {
    const int i = __float_as_int(v); int r;
    if (ctrl_sel == 0) r = __builtin_amdgcn_update_dpp(i, i, 0xB1, 0xF, 0xF, false);
    else if (ctrl_sel == 1) r = __builtin_amdgcn_update_dpp(i, i, 0x4E, 0xF, 0xF, false);
    else if (ctrl_sel == 2) r = __builtin_amdgcn_update_dpp(i, i, 0x141, 0xF, 0xF, false);
    else r = __builtin_amdgcn_update_dpp(i, i, 0x140, 0xF, 0xF, false);
    return __int_as_float(r); }
__device__ __forceinline__ float xsum16(float s) { const unsigned u = __float_as_uint(s); auto r = __builtin_amdgcn_permlane16_swap(u, u, false, false); return __uint_as_float(r[0]) + __uint_as_float(r[1]); }
__device__ __forceinline__ float xsum32(float s) { const unsigned u = __float_as_uint(s); auto r = __builtin_amdgcn_permlane32_swap(u, u, false, false); return __uint_as_float(r[0]) + __uint_as_float(r[1]); }
__device__ __forceinline__ float xmax32(float s) { const unsigned u = __float_as_uint(s); auto r = __builtin_amdgcn_permlane32_swap(u, u, false, false); return fmaxf(__uint_as_float(r[0]), __uint_as_float(r[1])); }
__device__ __forceinline__ float sum8(float v) { v += dpp_f(v, 0); v += dpp_f(v, 1); v += dpp_f(v, 2); return v; }
__device__ __forceinline__ float wave_sum(float v) { v = sum8(v); v += dpp_f(v, 3); v = xsum16(v); return xsum32(v); }
__device__ __forceinline__ float sigmoidf(float x) { return __builtin_amdgcn_rcpf(1.f + __builtin_amdgcn_exp2f(-x * LOG2E)); }
__device__ __forceinline__ float siluf(float x) { return x * sigmoidf(x); }
}

namespace pg8 {
constexpr int BM = 256, BK = 64, HALF = 128, HTB = HALF * BK * 2, STAGE_BYTES = 8 * HTB, NXCD = 8, WGM = 8;
__host__ __device__ __forceinline__ int lds_byte(int r, int c) { const int st = (r >> 4) * 2 + (c >> 5), rr = r & 15, cc = c & 31, ob = rr * 64 + cc * 2; return st * 1024 + (ob ^ (((ob >> 9) & 1) << 5)); }
__host__ __device__ __forceinline__ void stage_rc(int b, int& R, int& C) { const int st = b / 1024, sb = b % 1024, swz = sb ^ (((sb >> 9) & 1) << 5); R = (st >> 1) * 16 + swz / 64; C = (st & 1) * 32 + (swz % 64) / 2; }
__host__ __device__ __forceinline__ int perm32(int rho) { const int n = rho >> 4, i = rho & 15; return 8 * (i >> 2) + 4 * n + (i & 3); }

struct Unit { int pm, pn; const char* A; const char* B; int tag; int r0, rend, y0; };
__device__ __forceinline__ const char* uni_ptr(const char* p) { const unsigned long long v = (unsigned long long)p; const unsigned lo = __builtin_amdgcn_readfirstlane((unsigned)v), hi = __builtin_amdgcn_readfirstlane((unsigned)(v >> 32)); return (const char*)(((unsigned long long)hi << 32) | lo); }
struct Cfg { unsigned lda, ldb; int K; };

__device__ __forceinline__ bool static_tile(int i, int G, int c, int nM, int nN, int& pm, int& pn) {
    const int nwg = nM * nN; const long L = (long)i * G + c; if (L >= nwg) return false;
    int wgid = (int)L; { const int q = nwg / NXCD, r = nwg % NXCD, xcd = wgid % NXCD, off = wgid / NXCD; wgid = (xcd < r ? xcd * (q + 1) : r * (q + 1) + (xcd - r) * q) + off; }
    const int nig = WGM * nN, gid = wgid / nig, fm = gid * WGM, gsz = (nM - fm) < WGM ? (nM - fm) : WGM;
    pm = fm + ((wgid % nig) % gsz); pn = (wgid % nig) / gsz; return true;
}
struct DenseSched {
    int nM, nN, G, c; const char* A; const char* B; size_t tA, tB;
    __device__ __forceinline__ bool next(int i, Unit& u) const { if (!static_tile(i, G, c, nM, nN, u.pm, u.pn)) return false; u.A = A + (size_t)u.pm * tA; u.B = B + (size_t)u.pn * tB; u.tag = 0; return true; }
    __device__ __forceinline__ int row(const Unit&, int r) const { return r; }
};

template <class Epi, class Sched, bool GATHER>
__device__ __forceinline__ void gemm_phase(LAS unsigned char* lds, const Cfg g, const Sched& S, const Epi& E, int wv_) {
    int tid_ = wv_ * 64 + mk::lane_id(); asm volatile("" : "+v"(tid_));
    const int tid = tid_, wid = __builtin_amdgcn_readfirstlane(tid >> 6), lane = tid & 63, wr = wid >> 2, wc = wid & 3, fr = lane & 15, fq = lane >> 4;
    const int nt = g.K / BK;
    int RA[2], CA2[2]; unsigned vB[2], vAc[2][2], vAn[2][2];
#pragma unroll
    for (int i = 0; i < 2; ++i) { int R, C; stage_rc(tid * 16 + i * 8192, R, C); const int Rb = Epi::PERM ? (64 * (R >> 5) + 16 * ((R & 15) >> 2) + 4 * ((R >> 4) & 1) + (R & 3)) : R;
        RA[i] = R; CA2[i] = C * 2; vB[i] = (unsigned)Rb * g.ldb + (unsigned)C * 2u; }
    const size_t kstep = (size_t)(BK * 2);
    const size_t hB = (size_t)(Epi::PERM ? 8 : HALF) * g.ldb;
    const unsigned ldsw = (unsigned)wid * 1024u;
    const int aoff = lds_byte(wr * 64 + fr, fq * 8), boff = lds_byte(wc * 32 + fr, fq * 8);
#define PG8_SA(b, h) (((b) * 2 + (h)) * HTB)
#define PG8_SB(b, h) ((4 + (b) * 2 + (h)) * HTB)
#define PG8_STAGE(bufoff, gbase, voff) do { const char* _gb = uni_ptr((const char*)(gbase)); _Pragma("unroll") for (int _i = 0; _i < 2; ++_i) \
        __builtin_amdgcn_global_load_lds((const unsigned*)(_gb + (voff)[_i]), (LAS unsigned*)(lds + (bufoff) + ldsw + _i * 8192), 16, 0, 0); } while (0)
#define PG8_LDA(dst, b, h) do { _Pragma("unroll") for (int m = 0; m < 4; ++m) _Pragma("unroll") for (int k = 0; k < 2; ++k) dst[m][k] = *(const LAS bf16x8*)(lds + PG8_SA(b, h) + aoff + m * 2048 + k * 1024); } while (0)
#define PG8_LDB(dst, b, h) do { _Pragma("unroll") for (int n = 0; n < 2; ++n) _Pragma("unroll") for (int k = 0; k < 2; ++k) dst[n][k] = *(const LAS bf16x8*)(lds + PG8_SB(b, h) + boff + n * 2048 + k * 1024); } while (0)
#define PG8_MMA(ai, bj, At, Bt) do { __builtin_amdgcn_s_setprio(1); _Pragma("unroll") for (int m = 0; m < 4; ++m) _Pragma("unroll") for (int n = 0; n < 2; ++n) _Pragma("unroll") for (int k = 0; k < 2; ++k) \
        acc[ai][bj][m][n] = __builtin_amdgcn_mfma_f32_16x16x32_bf16(Bt[n][k], At[m][k], acc[ai][bj][m][n], 0, 0, 0); __builtin_amdgcn_s_setprio(0); } while (0)
#define PG8_WAIT_V(n) asm volatile("s_waitcnt vmcnt(" #n ")" ::: "memory")
#define PG8_WAIT_L(n) asm volatile("s_waitcnt lgkmcnt(" #n ")" ::: "memory")
#define PG8_BAR __builtin_amdgcn_s_barrier()
#define PG8_SCHED __builtin_amdgcn_sched_barrier(0)
#define PG8_VOFF(dst, u) do { _Pragma("unroll") for (int _h = 0; _h < 2; ++_h) _Pragma("unroll") for (int _i = 0; _i < 2; ++_i) \
        dst[_h][_i] = (unsigned)S.row(u, _h * HALF + RA[_i]) * g.lda + (unsigned)CA2[_i]; } while (0)
    Unit cur, nxt; int ui = 0;
    if (!S.next(0, cur)) return;
    f32x4 acc[2][2][4][2];
#pragma unroll
    for (int a = 0; a < 2; ++a)
#pragma unroll
        for (int b = 0; b < 2; ++b)
#pragma unroll
            for (int m = 0; m < 4; ++m)
#pragma unroll
                for (int n = 0; n < 2; ++n) acc[a][b][m][n] = (f32x4){0.f, 0.f, 0.f, 0.f};
    bf16x8 At[4][2], B0[2][2], B1[2][2];
    const char* cA = uni_ptr(cur.A); const char* cB = uni_ptr(cur.B);
    PG8_VOFF(vAc, cur);
    PG8_STAGE(PG8_SB(0, 0), cB, vB); PG8_STAGE(PG8_SB(0, 1), cB + hB, vB); PG8_STAGE(PG8_SA(0, 0), cA, vAc[0]); PG8_STAGE(PG8_SA(0, 1), cA, vAc[1]);
    if (wr == 1) PG8_BAR;
    PG8_WAIT_V(2); PG8_BAR;
    PG8_STAGE(PG8_SB(1, 0), cB + kstep, vB); PG8_STAGE(PG8_SA(1, 0), cA + kstep, vAc[0]); PG8_STAGE(PG8_SB(1, 1), cB + hB + kstep, vB);
    PG8_WAIT_V(6); PG8_BAR;
    for (;;) {
        const bool has_next = S.next(ui + 1, nxt);
        const char* nA = uni_ptr(has_next ? nxt.A : cA); const char* nB = uni_ptr(has_next ? nxt.B : cB);
        if constexpr (GATHER) { if (has_next) { PG8_VOFF(vAn, nxt); } else {
#pragma unroll
            for (int _h = 0; _h < 2; ++_h)
#pragma unroll
                for (int _i = 0; _i < 2; ++_i) vAn[_h][_i] = vAc[_h][_i]; } }
        for (int t = 0; t < nt; t += 2) {
            const bool last = (t == nt - 2);
            asm volatile("" : "+v"(vB[0]), "+v"(vB[1]), "+v"(vAc[0][0]), "+v"(vAc[0][1]), "+v"(vAc[1][0]), "+v"(vAc[1][1]));
            const char* a1 = cA + (size_t)(t + 1) * kstep;
            const char* a2 = uni_ptr(last ? nA : cA + (size_t)(t + 2) * kstep); const char* b2 = uni_ptr(last ? nB : cB + (size_t)(t + 2) * kstep);
            const char* a3 = a2 + kstep; const char* b3 = b2 + kstep;
            unsigned w0[2], w1[2];
#pragma unroll
            for (int _i = 0; _i < 2; ++_i) { if constexpr (GATHER) { w0[_i] = last ? vAn[0][_i] : vAc[0][_i]; w1[_i] = last ? vAn[1][_i] : vAc[1][_i]; } else { w0[_i] = vAc[0][_i]; w1[_i] = vAc[1][_i]; } }
            PG8_LDB(B0, 0, 0); PG8_LDB(B1, 0, 1); PG8_SCHED; PG8_LDA(At, 0, 0); PG8_STAGE(PG8_SA(1, 1), a1, vAc[1]);
            PG8_WAIT_V(8); PG8_WAIT_L(0); PG8_BAR; PG8_MMA(0, 0, At, B0); PG8_MMA(0, 1, At, B1); PG8_BAR; PG8_SCHED;
            PG8_LDA(At, 0, 1); PG8_STAGE(PG8_SB(0, 0), b2, vB); PG8_STAGE(PG8_SB(0, 1), b2 + hB, vB); PG8_STAGE(PG8_SA(0, 0), a2, w0);
            PG8_WAIT_V(8); PG8_WAIT_L(0); PG8_BAR; PG8_MMA(1, 0, At, B0); PG8_MMA(1, 1, At, B1); PG8_BAR; PG8_SCHED;
            PG8_LDB(B0, 1, 0); PG8_LDB(B1, 1, 1); PG8_SCHED; PG8_LDA(At, 1, 0); PG8_STAGE(PG8_SA(0, 1), a2, w1);
            PG8_WAIT_V(8); PG8_WAIT_L(0); PG8_BAR; PG8_MMA(0, 0, At, B0); PG8_MMA(0, 1, At, B1); PG8_BAR; PG8_SCHED;
            PG8_LDA(At, 1, 1); PG8_STAGE(PG8_SB(1, 0), b3, vB); PG8_STAGE(PG8_SB(1, 1), b3 + hB, vB); PG8_STAGE(PG8_SA(1, 0), a3, w0);
            PG8_WAIT_V(8); PG8_WAIT_L(0); PG8_BAR; PG8_MMA(1, 0, At, B0); PG8_MMA(1, 1, At, B1); PG8_BAR; PG8_SCHED;
        }
        if (wr == 0) PG8_BAR;
        const bool keep = E(acc, cur, wr, wc, fr, fq);
        if (!has_next) break;
        if (!keep) {
#pragma unroll
            for (int a = 0; a < 2; ++a)
#pragma unroll
                for (int b = 0; b < 2; ++b)
#pragma unroll
                    for (int m = 0; m < 4; ++m)
#pragma unroll
                        for (int n = 0; n < 2; ++n) acc[a][b][m][n] = (f32x4){0.f, 0.f, 0.f, 0.f};
        }
        cur = nxt; cA = nA; cB = nB; ++ui;
        if constexpr (GATHER) {
#pragma unroll
            for (int _h = 0; _h < 2; ++_h)
#pragma unroll
                for (int _i = 0; _i < 2; ++_i) vAc[_h][_i] = vAn[_h][_i]; }
        if (wr == 1) PG8_BAR;
    }
    PG8_WAIT_V(0);
    PG8_BAR;
#undef PG8_SA
#undef PG8_SB
#undef PG8_STAGE
#undef PG8_LDA
#undef PG8_LDB
#undef PG8_MMA
#undef PG8_WAIT_V
#undef PG8_WAIT_L
#undef PG8_BAR
#undef PG8_SCHED
#undef PG8_VOFF
}
}

namespace mk {
struct P {
    const float *x, *p, *g_mix, *w_in, *w_pool_mix, *pool_scale, *w_a, *q_gain, *k_gain, *sinks, *w_b, *w_gate, *b_gate, *w_out, *g_ffn, *w_router, *router_bias,
                *w_eg, *w_eu, *w_ed, *w_sg, *w_su, *w_sd, *g_ple, *w_pg, *w_pp, *g_post;
    float* out; char* ws;
};

struct RowBf { const bf16_t* base; int ld; __device__ __forceinline__ float4 load4(int r, int k) const { const uint2 v = *(const uint2*)(base + (size_t)r * ld + k);
    return make_float4(bf2f(v.x & 0xffffu), bf2f(v.x >> 16), bf2f(v.y & 0xffffu), bf2f(v.y >> 16)); } };
struct RowBfIdx { const bf16_t* base; int ld; const int* lst; int nvalid; int shift;
    __device__ __forceinline__ float4 load4(int r, int k) const { const int row = (r < nvalid ? lst[r] : lst[0]) >> shift; const uint2 v = *(const uint2*)(base + (size_t)row * ld + k);
    return make_float4(bf2f(v.x & 0xffffu), bf2f(v.x >> 16), bf2f(v.y & 0xffffu), bf2f(v.y >> 16)); } };
template <class ARow>
__device__ __forceinline__ void gemm_tile(int vt, ARow arow, const float* __restrict__ B, int ldb, int K, int n0, float (&acc)[4][4], float (*As)[68], float (*Bs)[64]) {
    const int tx = vt & 15, ty = vt >> 4;
#pragma unroll
    for (int i = 0; i < 4; ++i)
#pragma unroll
        for (int j = 0; j < 4; ++j) acc[i][j] = 0.f;
    const int ar = vt >> 2, ak = (vt & 3) * 4;
    const int bk = vt >> 4, bn = (vt & 15) * 4;
#pragma unroll 1
    for (int k0 = 0; k0 < K; k0 += 16) {
        const float4 av = arow.load4(ar, k0 + ak);
        const float4 bv = *(const float4*)(B + (size_t)(k0 + bk) * ldb + n0 + bn);
        __syncthreads();
        As[ak + 0][ar] = av.x; As[ak + 1][ar] = av.y; As[ak + 2][ar] = av.z; As[ak + 3][ar] = av.w;
        *(float4*)&Bs[bk][bn] = bv;
        __syncthreads();
#pragma unroll
        for (int kk = 0; kk < 16; ++kk) {
            const float4 a = *(const float4*)&As[kk][ty * 4];
            const float4 b = *(const float4*)&Bs[kk][tx * 4];
            const float aa[4] = {a.x, a.y, a.z, a.w}, bb[4] = {b.x, b.y, b.z, b.w};
#pragma unroll
            for (int i = 0; i < 4; ++i)
#pragma unroll
                for (int j = 0; j < 4; ++j) acc[i][j] += aa[i] * bb[j];
        }
    }
}
#define VB_LOOP(nvb) for (int _it = 0, _nit = ((nvb) + 2 * (int)gridDim.x - 1) / (2 * (int)gridDim.x); _it < _nit; ++_it) { \
    const int _raw = _it * 2 * (int)gridDim.x + (int)blockIdx.x * 2 + half; const bool vvalid = _raw < (nvb); const int vb = vvalid ? _raw : 0;
#define VB_END }
#define FOR_IJ _Pragma("unroll") for (int i = 0; i < 4; ++i) _Pragma("unroll") for (int j = 0; j < 4; ++j)

struct TItem { const float* src; int ld; bf16_t* dst; int ldk; const float* ks; int gu; };
__device__ __forceinline__ TItem ti_plain(const float* W, int K, int N, bf16_t* dstm, int row_off, int item, const float* kscale = nullptr) {
    const int nblk = N / 32, kb = item / nblk, nb = item % nblk;
    return TItem{W + (size_t)(64 * kb) * N + 32 * nb, N, dstm + (size_t)(row_off + 32 * nb) * K + 64 * kb, K, kscale ? kscale + 64 * kb : nullptr, 0}; }
__device__ __forceinline__ TItem ti_gu(const float* W, bf16_t* dstm, int up, int item, const float* kscale) {
    const int kb = item / 8, nb = item % 8, c0 = 32 * nb;
    return TItem{W + (size_t)(64 * kb) * 256 + c0, 256, dstm + (size_t)((c0 >> 7) * 256 + 2 * (c0 & 127) + 8 * up) * 1024 + 64 * kb, 1024, kscale + 64 * kb, 1}; }
__device__ __forceinline__ TItem ti_gate(const float* W, bf16_t* wcat, int item) {
    const int kb = item / 64, nb = item % 64, c0 = 32 * nb, ab = c0 >> 10, oc = c0 & 1023;
    return TItem{W + (size_t)(64 * kb) * (2 * D) + c0, 2 * D, wcat + (size_t)(IND + 256 * (oc >> 7) + 2 * (oc & 127) + 8 * ab) * D + 64 * kb, D, nullptr, 1}; }
__device__ __forceinline__ void ti_load(const TItem& t, f32x4 (&v)[8], int lane) {
#pragma unroll
    for (int i = 0; i < 8; ++i) { v[i] = *(const f32x4*)(t.src + (size_t)(8 * (lane >> 3) + i) * t.ld + 4 * (lane & 7)); if (t.ks) v[i] = v[i] * t.ks[8 * (lane >> 3) + i]; } }
__device__ __forceinline__ void ti_finish(const TItem& t, const f32x4 (&v)[8], LAS float*, int lane) {
#pragma unroll
    for (int j = 0; j < 4; ++j) { u32x4 o; o.x = pk2(v[0][j], v[1][j]); o.y = pk2(v[2][j], v[3][j]); o.z = pk2(v[4][j], v[5][j]); o.w = pk2(v[6][j], v[7][j]);
        const int n_ = 4 * (lane & 7) + j; *(u32x4*)(t.dst + (size_t)(t.gu ? 2 * (n_ & ~7) + (n_ & 7) : n_) * t.ldk + 8 * (lane >> 3)) = o; }
}

struct EpiG1 {
    static constexpr bool PERM = true;
    bf16_t* u; bf16_t* gates; const float* bg;
    __device__ __forceinline__ bool operator()(f32x4 (&acc)[2][2][4][2], const pg8::Unit& un, int wr, int wc, int fr, int fq) const {
        const int row0 = un.pm * 256 + wr * 64 + fr;
        if (un.pn < 5) { const int col0 = un.pn * 256 + wc * 64 + 16 * fq;
#pragma unroll
            for (int ai = 0; ai < 2; ++ai)
#pragma unroll
                for (int m = 0; m < 4; ++m) { bf16_t* rowp = u + (size_t)(row0 + ai * 128 + m * 16) * IND + col0;
#pragma unroll
                    for (int bj = 0; bj < 2; ++bj) { const f32x4 v0 = acc[ai][bj][m][0], v1 = acc[ai][bj][m][1];
                        u32x4 w; w.x = cvt_pk_bf16(v0[0], v0[1]); w.y = cvt_pk_bf16(v0[2], v0[3]); w.z = cvt_pk_bf16(v1[0], v1[1]); w.w = cvt_pk_bf16(v1[2], v1[3]);
                        *(u32x4*)(rowp + bj * 8) = w; } }
        } else { const int c0 = (un.pn - 5) * 128 + wc * 32 + 8 * fq;
            const f32x4 ba0 = *(const f32x4*)(bg + c0), ba1 = *(const f32x4*)(bg + c0 + 4), bb0 = *(const f32x4*)(bg + D + c0), bb1 = *(const f32x4*)(bg + D + c0 + 4);
#pragma unroll
            for (int ai = 0; ai < 2; ++ai)
#pragma unroll
                for (int m = 0; m < 4; ++m) { bf16_t* rowp = gates + (size_t)(row0 + ai * 128 + m * 16) * 2 * D + c0;
                    const f32x4 za0 = acc[ai][0][m][0] + ba0, za1 = acc[ai][0][m][1] + ba1, zb0 = acc[ai][1][m][0] + bb0, zb1 = acc[ai][1][m][1] + bb1;
                    f32x4 r0, r1, g0, g1;
#pragma unroll
                    for (int q = 0; q < 4; ++q) { g0[q] = sigmoidf(zb0[q]); g1[q] = sigmoidf(zb1[q]);
                        r0[q] = sigmoidf(za0[q]) * __builtin_amdgcn_rcpf(fmaxf(g0[q], 1e-12f)); r1[q] = sigmoidf(za1[q]) * __builtin_amdgcn_rcpf(fmaxf(g1[q], 1e-12f)); }
                    u32x4 w; w.x = cvt_pk_bf16(r0[0], r0[1]); w.y = cvt_pk_bf16(r0[2], r0[3]); w.z = cvt_pk_bf16(r1[0], r1[1]); w.w = cvt_pk_bf16(r1[2], r1[3]);
                    *(u32x4*)rowp = w;
                    w.x = cvt_pk_bf16(g0[0], g0[1]); w.y = cvt_pk_bf16(g0[2], g0[3]); w.z = cvt_pk_bf16(g1[0], g1[1]); w.w = cvt_pk_bf16(g1[2], g1[3]);
                    *(u32x4*)(rowp + D) = w; } }
        return false;
    }
};
struct EpiPP {
    static constexpr bool PERM = true;
    bf16_t* pp; float* rss;
    __device__ __forceinline__ bool operator()(f32x4 (&acc)[2][2][4][2], const pg8::Unit& un, int wr, int wc, int fr, int fq) const {
        const int row0 = un.pm * 256 + wr * 64 + fr, col0 = un.pn * 256 + wc * 64 + 16 * fq;
#pragma unroll
        for (int ai = 0; ai < 2; ++ai)
#pragma unroll
            for (int m = 0; m < 4; ++m) { const int row = row0 + ai * 128 + m * 16; bf16_t* rowp = pp + (size_t)row * D + col0; float s = 0.f;
#pragma unroll
                for (int bj = 0; bj < 2; ++bj) { const f32x4 v0 = acc[ai][bj][m][0], v1 = acc[ai][bj][m][1];
                    s += (v0[0] * v0[0] + v0[1] * v0[1]) + (v0[2] * v0[2] + v0[3] * v0[3]) + (v1[0] * v1[0] + v1[1] * v1[1]) + (v1[2] * v1[2] + v1[3] * v1[3]);
                    u32x4 w; w.x = cvt_pk_bf16(v0[0], v0[1]); w.y = cvt_pk_bf16(v0[2], v0[3]); w.z = cvt_pk_bf16(v1[0], v1[1]); w.w = cvt_pk_bf16(v1[2], v1[3]);
                    *(u32x4*)(rowp + bj * 8) = w; }
                s = xsum32(xsum16(s));
                if (fq == 0) atomicAdd(rss + row, s); }
        return false;
    }
};


struct EpiBf16Plain {
    static constexpr bool PERM = true;
    bf16_t* O; int ld;
    __device__ __forceinline__ bool operator()(f32x4 (&acc)[2][2][4][2], const pg8::Unit& un, int wr, int wc, int fr, int fq) const {
        const int row0 = un.pm * 256 + wr * 64 + fr, col0 = un.pn * 256 + wc * 64 + 16 * fq;
#pragma unroll
        for (int ai = 0; ai < 2; ++ai)
#pragma unroll
            for (int m = 0; m < 4; ++m) { bf16_t* rowp = O + (size_t)(row0 + ai * 128 + m * 16) * ld + col0;
#pragma unroll
                for (int bj = 0; bj < 2; ++bj) { const f32x4 v0 = acc[ai][bj][m][0], v1 = acc[ai][bj][m][1];
                    u32x4 w; w.x = cvt_pk_bf16(v0[0], v0[1]); w.y = cvt_pk_bf16(v0[2], v0[3]); w.z = cvt_pk_bf16(v1[0], v1[1]); w.w = cvt_pk_bf16(v1[2], v1[3]);
                    *(u32x4*)(rowp + bj * 8) = w; } }
        return false;
    }
};
struct PPSched {
    int G, c; const char* A; const char* B;
    __device__ __forceinline__ bool next(int i, pg8::Unit& u) const {
        if (G != 256) { if (!pg8::static_tile(i, G, c, T / 256, D / 256, u.pm, u.pn)) return false; }
        else { int idx; if (c < 128) { if (i > 0) return false; idx = c; } else { if (i > 2) return false; idx = 128 + (c - 128) * 3 + i; } u.pm = idx >> 2; u.pn = idx & 3; }
        u.A = A + (size_t)u.pm * 256 * PLE * 2; u.B = B + (size_t)u.pn * 256 * PLE * 2; u.tag = 0; return true; }
    __device__ __forceinline__ int row(const pg8::Unit&, int r) const { return r; }
};
struct P6Sched {
    int G, c; const char* A; const char* B;
    __device__ __forceinline__ bool next(int i, pg8::Unit& u) const {
        if (G != 256) { if (!pg8::static_tile(i, G, c, T / 256, 3, u.pm, u.pn)) return false; }
        else if (c < 128) { if (i > 0) return false; u.pm = c; u.pn = 2; }
        else { if (i > 1) return false; const int idx = (c - 128) * 2 + i; u.pm = idx >> 1; u.pn = idx & 1; }
        u.A = A + (size_t)u.pm * 256 * D * 2; u.B = B + (size_t)u.pn * 256 * D * 2; u.tag = 0; return true; }
    __device__ __forceinline__ int row(const pg8::Unit&, int r) const { return r; }
};
struct MixSched {
    int G, c; const char* A; const char* B;
    __device__ __forceinline__ bool next(int i, pg8::Unit& u) const { if (!pg8::static_tile(i, G, c, T / 256, 2, u.pm, u.pn)) return false;
        u.A = A + (size_t)u.pm * 256 * POOLD * 2 + (size_t)u.pn * 512; u.B = B + (size_t)u.pn * 256 * 256 * 2; u.tag = 0; return true; }
    __device__ __forceinline__ int row(const pg8::Unit&, int r) const { return r; }
};
struct MergedSched {
    int G, c; const char* A0; const char* A1; const char* B0; const char* B1;
    __device__ __forceinline__ bool next(int i, pg8::Unit& u) const { if (!pg8::static_tile(i >> 1, G, c, T / 256, D / 256, u.pm, u.pn)) return false;
        const int br = i & 1; u.A = (br ? A1 : A0) + (size_t)u.pm * 256 * 512 * 2; u.B = (br ? B1 : B0) + (size_t)u.pn * 256 * 512 * 2; u.tag = br; return true; }
    __device__ __forceinline__ int row(const pg8::Unit&, int r) const { return r; }
};
struct EpiMerged {
    static constexpr bool PERM = true;
    const bf16_t* gates; bf16_t* O;
    __device__ __forceinline__ bool operator()(f32x4 (&acc)[2][2][4][2], const pg8::Unit& un, int wr, int wc, int fr, int fq) const {
        const int row0 = un.pm * 256 + wr * 64 + fr, col0 = un.pn * 256 + wc * 64 + 16 * fq;
        u32x4 gv[8][2];
#pragma unroll
        for (int j = 0; j < 8; ++j)
#pragma unroll
            for (int bj = 0; bj < 2; ++bj) gv[j][bj] = *(const u32x4*)(gates + (size_t)(row0 + (j >> 2) * 128 + (j & 3) * 16) * 2 * D + (un.tag == 0 ? 0 : D) + col0 + bj * 8);
#pragma unroll
        for (int ai = 0; ai < 2; ++ai)
#pragma unroll
            for (int m = 0; m < 4; ++m) { const size_t row = (size_t)(row0 + ai * 128 + m * 16);
#pragma unroll
                for (int bj = 0; bj < 2; ++bj) { const u32x4 g4 = gv[ai * 4 + m][bj];
                    const float gf[8] = {bf2f(g4.x & 0xffffu), bf2f(g4.x >> 16), bf2f(g4.y & 0xffffu), bf2f(g4.y >> 16), bf2f(g4.z & 0xffffu), bf2f(g4.z >> 16), bf2f(g4.w & 0xffffu), bf2f(g4.w >> 16)};
                    if (un.tag == 0) {
#pragma unroll
                        for (int q = 0; q < 4; ++q) { acc[ai][bj][m][0][q] *= gf[q]; acc[ai][bj][m][1][q] *= gf[4 + q]; }
                    } else { const f32x4 v0 = acc[ai][bj][m][0], v1 = acc[ai][bj][m][1];
                        u32x4 w; w.x = cvt_pk_bf16(v0[0] * gf[0], v0[1] * gf[1]); w.y = cvt_pk_bf16(v0[2] * gf[2], v0[3] * gf[3]); w.z = cvt_pk_bf16(v1[0] * gf[4], v1[1] * gf[5]); w.w = cvt_pk_bf16(v1[2] * gf[6], v1[3] * gf[7]);
                        *(u32x4*)(O + row * D + col0 + bj * 8) = w; } } }
        return un.tag == 0;
    }
};
struct EpiResid {
    static constexpr bool PERM = true;
    const float* x; bf16_t* xb; float* rss;
    __device__ __forceinline__ bool operator()(f32x4 (&acc)[2][2][4][2], const pg8::Unit& un, int wr, int wc, int fr, int fq) const {
        const int row0 = un.pm * 256 + wr * 64 + fr, col0 = un.pn * 256 + wc * 64 + 16 * fq;
        f32x4 xv[2][4][2][2];
#pragma unroll
        for (int m = 0; m < 4; ++m)
#pragma unroll
            for (int bj = 0; bj < 2; ++bj) { const float* xp = x + (size_t)(row0 + m * 16) * D + col0 + bj * 8; xv[0][m][bj][0] = *(const f32x4*)xp; xv[0][m][bj][1] = *(const f32x4*)(xp + 4); }
#pragma unroll
        for (int ai = 0; ai < 2; ++ai) {
            u32x4 wv[4][2]; float sv[4];
#pragma unroll
            for (int m = 0; m < 4; ++m) { float s_ = 0.f;
#pragma unroll
                for (int bj = 0; bj < 2; ++bj) { const f32x4 v0 = xv[ai][m][bj][0] + acc[ai][bj][m][0], v1 = xv[ai][m][bj][1] + acc[ai][bj][m][1];
                    s_ += (v0[0] * v0[0] + v0[1] * v0[1]) + (v0[2] * v0[2] + v0[3] * v0[3]) + (v1[0] * v1[0] + v1[1] * v1[1]) + (v1[2] * v1[2] + v1[3] * v1[3]);
                    wv[m][bj].x = cvt_pk_bf16(v0[0], v0[1]); wv[m][bj].y = cvt_pk_bf16(v0[2], v0[3]); wv[m][bj].z = cvt_pk_bf16(v1[0], v1[1]); wv[m][bj].w = cvt_pk_bf16(v1[2], v1[3]); }
                sv[m] = xsum32(xsum16(s_)); }
            if (ai == 0) {
#pragma unroll
                for (int m = 0; m < 4; ++m)
#pragma unroll
                    for (int bj = 0; bj < 2; ++bj) { const float* xp = x + (size_t)(row0 + 128 + m * 16) * D + col0 + bj * 8; xv[1][m][bj][0] = *(const f32x4*)xp; xv[1][m][bj][1] = *(const f32x4*)(xp + 4); } }
#pragma unroll
            for (int m = 0; m < 4; ++m) { const int row = row0 + ai * 128 + m * 16;
#pragma unroll
                for (int bj = 0; bj < 2; ++bj) *(u32x4*)(xb + (size_t)row * D + col0 + bj * 8) = wv[m][bj];
                if (fq == 0) atomicAdd(rss + row, sv[m]); }
        }
        return false;
    }
};
struct EpiShared {
    static constexpr bool PERM = true;
    bf16_t* act; float* lg; const float* rss;
    __device__ __forceinline__ bool operator()(f32x4 (&acc)[2][2][4][2], const pg8::Unit& un, int wr, int wc, int fr, int fq) const {
        const int row0 = un.pm * 256 + wr * 64 + fr;
        float rs8[8];
#pragma unroll
        for (int j = 0; j < 8; ++j) rs8[j] = rss[row0 + (j >> 2) * 128 + (j & 3) * 16];
#pragma unroll
        for (int j = 0; j < 8; ++j) rs8[j] = rsqrtf(rs8[j] * (1.f / D) + EPS);
#pragma unroll
        for (int ai = 0; ai < 2; ++ai)
#pragma unroll
            for (int m = 0; m < 4; ++m) { const int row = row0 + ai * 128 + m * 16; const float rs = rs8[ai * 4 + m];
                if (un.pn < 2) { const f32x4 g0 = acc[ai][0][m][0] * rs, g1 = acc[ai][0][m][1] * rs, u0 = acc[ai][1][m][0] * rs, u1 = acc[ai][1][m][1] * rs;
                    u32x4 w; w.x = cvt_pk_bf16(siluf(g0[0]) * u0[0], siluf(g0[1]) * u0[1]); w.y = cvt_pk_bf16(siluf(g0[2]) * u0[2], siluf(g0[3]) * u0[3]);
                    w.z = cvt_pk_bf16(siluf(g1[0]) * u1[0], siluf(g1[1]) * u1[1]); w.w = cvt_pk_bf16(siluf(g1[2]) * u1[2], siluf(g1[3]) * u1[3]);
                    *(u32x4*)(act + (size_t)row * SD + un.pn * 128 + wc * 32 + 8 * fq) = w;
                } else if (wc == 0) { float* lp = lg + (size_t)row * NE + 16 * fq;
                    *(f32x4*)lp = acc[ai][0][m][0] * rs; *(f32x4*)(lp + 4) = acc[ai][0][m][1] * rs; *(f32x4*)(lp + 8) = acc[ai][1][m][0] * rs; *(f32x4*)(lp + 12) = acc[ai][1][m][1] * rs; } }
        return false;
    }
};
struct EpiFinal {
    static constexpr bool PERM = true;
    float* o; const bf16_t* x2; const bf16_t* pp; const float* rss3_; const float* rsspp_; const float* gp;
    __device__ __forceinline__ bool operator()(f32x4 (&acc)[2][2][4][2], const pg8::Unit& un, int wr, int wc, int fr, int fq) const {
        const int row0 = un.pm * 256 + wr * 64 + fr, col0 = un.pn * 256 + wc * 64 + 16 * fq;
        f32x4 gv[2][2];
#pragma unroll
        for (int bj = 0; bj < 2; ++bj)
#pragma unroll
            for (int n = 0; n < 2; ++n) gv[bj][n] = *(const f32x4*)(gp + col0 + bj * 8 + n * 4);
        u32x4 xv[2][4][2], pv[2][4][2]; float r3[2][4], rp[2][4];
#define EF_LOAD(ai_) do { _Pragma("unroll") for (int m = 0; m < 4; ++m) { const int row = row0 + (ai_) * 128 + m * 16; r3[ai_][m] = rss3_[row]; rp[ai_][m] = rsspp_[row]; \
        _Pragma("unroll") for (int bj = 0; bj < 2; ++bj) { const size_t o2 = (size_t)row * D + col0 + bj * 8; xv[ai_][m][bj] = *(const u32x4*)(x2 + o2); pv[ai_][m][bj] = *(const u32x4*)(pp + o2); } } } while (0)
        EF_LOAD(0);
#pragma unroll
        for (int ai = 0; ai < 2; ++ai) {
            f32x4 res[4][2][2];
#pragma unroll
            for (int m = 0; m < 4; ++m) { const float q3 = rsqrtf(r3[ai][m] * (1.f / D) + EPS), qp = rsqrtf(rp[ai][m] * (1.f / D) + EPS);
#pragma unroll
                for (int bj = 0; bj < 2; ++bj) { const u32x4 xq = xv[ai][m][bj], pq = pv[ai][m][bj]; const f32x4 a0 = acc[ai][bj][m][0] * q3, a1 = acc[ai][bj][m][1] * q3; f32x4 v0, v1;
                    v0[0] = bf2f(xq.x & 0xffffu) + sigmoidf(a0[0]) * bf2f(pq.x & 0xffffu) * qp * gv[bj][0][0]; v0[1] = bf2f(xq.x >> 16) + sigmoidf(a0[1]) * bf2f(pq.x >> 16) * qp * gv[bj][0][1];
                    v0[2] = bf2f(xq.y & 0xffffu) + sigmoidf(a0[2]) * bf2f(pq.y & 0xffffu) * qp * gv[bj][0][2]; v0[3] = bf2f(xq.y >> 16) + sigmoidf(a0[3]) * bf2f(pq.y >> 16) * qp * gv[bj][0][3];
                    v1[0] = bf2f(xq.z & 0xffffu) + sigmoidf(a1[0]) * bf2f(pq.z & 0xffffu) * qp * gv[bj][1][0]; v1[1] = bf2f(xq.z >> 16) + sigmoidf(a1[1]) * bf2f(pq.z >> 16) * qp * gv[bj][1][1];
                    v1[2] = bf2f(xq.w & 0xffffu) + sigmoidf(a1[2]) * bf2f(pq.w & 0xffffu) * qp * gv[bj][1][2]; v1[3] = bf2f(xq.w >> 16) + sigmoidf(a1[3]) * bf2f(pq.w >> 16) * qp * gv[bj][1][3];
                    res[m][bj][0] = v0; res[m][bj][1] = v1; } }
            if (ai == 0) EF_LOAD(1);
#pragma unroll
            for (int m = 0; m < 4; ++m)
#pragma unroll
                for (int bj = 0; bj < 2; ++bj) { float* op = o + (size_t)(row0 + ai * 128 + m * 16) * D + col0 + bj * 8; *(f32x4*)op = res[m][bj][0]; *(f32x4*)(op + 4) = res[m][bj][1]; }
        }
#undef EF_LOAD
        return false;
    }
};
__device__ __forceinline__ int find_expert(const LAS int* mts, int mt) { int e = 0;
#pragma unroll 1
    for (; e < NE - 1; ++e) if (mt < mts[e + 1]) break;
    return e; }
struct RoutedUpSched {
    int G, c, nM; const LAS unsigned char* t2e; const int* tl; const char* A; const char* B;
    __device__ __forceinline__ bool next(int i, pg8::Unit& u) const { if (!pg8::static_tile(i, G, c, nM, 2, u.pm, u.pn)) return false;
        const int e = t2e[u.pm]; u.A = A; u.B = B + (size_t)e * 512 * D * 2 + (size_t)u.pn * 256 * D * 2; u.tag = e; return true; }
    __device__ __forceinline__ int row(const pg8::Unit& u, int r) const { const int aid = tl[u.pm * 256 + r]; return aid < 0 ? 0 : (aid >> 3); }
};
struct EpiRoutedUp {
    static constexpr bool PERM = true;
    bf16_t* act; const int2* ri; const float* wt;
    __device__ __forceinline__ bool operator()(f32x4 (&acc)[2][2][4][2], const pg8::Unit& un, int wr, int wc, int fr, int fq) const {
        const int row0 = un.pm * 256 + wr * 64 + fr;
        float rs8[8], w8[8];
#pragma unroll
        for (int j = 0; j < 8; ++j) { const int pos = row0 + (j >> 2) * 128 + (j & 3) * 16; rs8[j] = __int_as_float(ri[pos].y); w8[j] = wt[pos]; }
#pragma unroll
        for (int ai = 0; ai < 2; ++ai)
#pragma unroll
            for (int m = 0; m < 4; ++m) { const int pos = row0 + ai * 128 + m * 16; const float rs = rs8[ai * 4 + m], rw = rs * w8[ai * 4 + m];
                const f32x4 g0 = acc[ai][0][m][0] * rs, g1 = acc[ai][0][m][1] * rs, u0 = acc[ai][1][m][0] * rw, u1 = acc[ai][1][m][1] * rw;
                u32x4 o; o.x = cvt_pk_bf16(siluf(g0[0]) * u0[0], siluf(g0[1]) * u0[1]); o.y = cvt_pk_bf16(siluf(g0[2]) * u0[2], siluf(g0[3]) * u0[3]);
                o.z = cvt_pk_bf16(siluf(g1[0]) * u1[0], siluf(g1[1]) * u1[1]); o.w = cvt_pk_bf16(siluf(g1[2]) * u1[2], siluf(g1[3]) * u1[3]);
                *(u32x4*)(act + (size_t)pos * ED + un.pn * 128 + wc * 32 + 8 * fq) = o; }
        return false;
    }
};
struct DownSched {
    int G, c, r; const LAS int* lo; const LAS int* tst; const LAS unsigned char* t2e; const LAS int* cb; const char* Ar; const char* As_; const char* Br; const char* Bs_;
    __device__ __forceinline__ bool next(int i, pg8::Unit& u) const { const LAS int* ts = tst + r * 65; const int ntl = ts[64];
        if (!pg8::static_tile(i, G, c, ntl + TR / 256, 4, u.pm, u.pn)) return false;
        if (u.pm < ntl) { const int e = t2e[r * T2S + u.pm]; const int row0 = lo[r * 64 + e] + 256 * (u.pm - ts[e]);
            u.A = Ar + (size_t)row0 * ED * 2; u.B = Br + (size_t)e * D * ED * 2 + (size_t)u.pn * 256 * ED * 2; u.tag = 0; u.r0 = row0; u.rend = lo[(r + 1) * 64 + e]; u.y0 = cb[r * 64 + e] + 256 * (u.pm - ts[e]); }
        else { const int t0 = r * TR + 256 * (u.pm - ntl); u.A = As_ + (size_t)t0 * SD * 2; u.B = Bs_ + (size_t)u.pn * 256 * SD * 2; u.tag = 1; u.r0 = t0; u.rend = t0 + 256; u.y0 = 8 * TR + 256 * (u.pm - ntl); }
        return true; }
    __device__ __forceinline__ int row(const pg8::Unit&, int r_) const { return r_; }
};
__device__ __forceinline__ unsigned pack_fp8x4(f32x4 v) {
    const float a0 = __builtin_amdgcn_fmed3f(v[0], -448.f, 448.f), a1 = __builtin_amdgcn_fmed3f(v[1], -448.f, 448.f), a2 = __builtin_amdgcn_fmed3f(v[2], -448.f, 448.f), a3 = __builtin_amdgcn_fmed3f(v[3], -448.f, 448.f);
    int w = __builtin_amdgcn_cvt_pk_fp8_f32(a0, a1, 0, false); w = __builtin_amdgcn_cvt_pk_fp8_f32(a2, a3, w, true); return (unsigned)w; }
struct EpiDown {
    static constexpr bool PERM = true;
    unsigned char* Y;
    __device__ __forceinline__ bool operator()(f32x4 (&acc)[2][2][4][2], const pg8::Unit& un, int wr, int wc, int fr, int fq) const {
        const int rl0 = wr * 64 + fr;
#pragma unroll
        for (int ai = 0; ai < 2; ++ai)
#pragma unroll
            for (int m = 0; m < 4; ++m) { const int rl = rl0 + ai * 128 + m * 16;
                if (un.r0 + rl < un.rend) { unsigned char* yr = Y + (size_t)(un.y0 + rl) * 1024 + un.pn * 256 + wc * 64 + 16 * fq;
                    u32x4 o; o.x = pack_fp8x4(acc[ai][0][m][0]); o.y = pack_fp8x4(acc[ai][0][m][1]); o.z = pack_fp8x4(acc[ai][1][m][0]); o.w = pack_fp8x4(acc[ai][1][m][1]); *(u32x4*)yr = o; } }
        return false;
    }
};

#define XB_TMO      128
#define XB_XCNT(j)  (256  + 64 * (j))
#define XB_XSUB(j)  (1280 + 64 * (j))
#define XB_XGEN(j)  (2304 + 64 * (j))
#define XB_TOP      3328
#define XB_TOPGEN   3392
#define XCD_BAR_WORDS 3456
#define XB_SPIN_CAP (1u << 22)
__device__ __forceinline__ unsigned xb_ld(unsigned* p)              { return __hip_atomic_load(p, __ATOMIC_RELAXED, __HIP_MEMORY_SCOPE_AGENT); }
__device__ __forceinline__ unsigned xb_add(unsigned* p, unsigned v) { return __hip_atomic_fetch_add(p, v, __ATOMIC_RELAXED, __HIP_MEMORY_SCOPE_AGENT); }
__device__ __forceinline__ unsigned xb_xcc_id() { return (unsigned)__builtin_amdgcn_s_getreg((3 << 11) | 20) & 0xFu; }
#define XB_SPIN(cond, bar) do { unsigned _sp = 0; while (cond) { __builtin_amdgcn_s_sleep(1); \
    if ((++_sp & 255u) == 0u) { if (xb_ld(&(bar)[XB_TMO])) break; if (_sp > XB_SPIN_CAP) { atomicAdd(&(bar)[XB_TMO], 1u); break; } } } } while (0)
struct XcdBarrier { unsigned* bar; unsigned x; volatile LAS unsigned* st; };
__device__ __forceinline__ XcdBarrier xcd_barrier_post(unsigned* bar, volatile LAS unsigned* st, bool first_wave) {
    XcdBarrier b; b.bar = bar; b.x = xb_xcc_id(); b.st = st;
    if (lane_id() == 0 && first_wave) (void)xb_add(&bar[XB_XCNT(b.x)], 1u);
    return b;
}
__device__ __forceinline__ void xcd_barrier_complete(unsigned* bar, unsigned x, unsigned& nloc, unsigned& nx) {
    const unsigned G = gridDim.x * gridDim.y * gridDim.z;
    unsigned sum, cnt, mine, sp = 0u;
    for (;;) {
        sum = 0u; cnt = 0u; mine = 0u;
#pragma unroll
        for (unsigned j = 0; j < 16; ++j) { const unsigned c = xb_ld(&bar[XB_XCNT(j)]); sum += c; cnt += (c > 0u) ? 1u : 0u; mine = (j == x) ? c : mine; }
        if (sum == G) break;
        __builtin_amdgcn_s_sleep(1);
        if ((++sp & 255u) == 0u) { if (xb_ld(&bar[XB_TMO])) break; if (sp > XB_SPIN_CAP) { atomicAdd(&bar[XB_TMO], 1u); break; } }
    }
    nloc = mine > 0u ? mine : 1u; nx = cnt > 0u ? cnt : 1u;
}
__device__ __forceinline__ void xcd_barrier(const XcdBarrier& b, int tid) {
    asm volatile("s_waitcnt vmcnt(0)" ::: "memory");
    __syncthreads();
    if (tid == 0) {
        unsigned* bar = b.bar; unsigned bx = b.x; asm volatile("" : "+s"(bx));
        __builtin_amdgcn_s_waitcnt(0);
        unsigned nloc = b.st[0], nx = b.st[1];
        if (nloc == 0u) { xcd_barrier_complete(bar, bx, nloc, nx); b.st[0] = nloc; b.st[1] = nx; }
        const unsigned old = xb_add(&bar[XB_XSUB(bx)], 1u);
        const unsigned gen = old / nloc;
        if (old + 1u == (gen + 1u) * nloc) {
            __builtin_amdgcn_fence(__ATOMIC_RELEASE, "agent");
            asm volatile("s_waitcnt vmcnt(0)" ::: "memory");
            const unsigned og = xb_add(&bar[XB_TOP], 1u);
            const unsigned tg = og / nx;
            if (og + 1u == (tg + 1u) * nx) xb_add(&bar[XB_TOPGEN], 1u);
            else XB_SPIN(xb_ld(&bar[XB_TOPGEN]) == tg, bar);
            __builtin_amdgcn_fence(__ATOMIC_ACQUIRE, "agent");
            xb_add(&bar[XB_XGEN(bx)], 1u);
            asm volatile("s_waitcnt vmcnt(0)" ::: "memory");
        } else {
            XB_SPIN(xb_ld(&bar[XB_XGEN(bx)]) == gen, bar);
            __builtin_amdgcn_fence(__ATOMIC_ACQUIRE, "agent");
            asm volatile("s_waitcnt vmcnt(0)" ::: "memory");
        }
    }
    __syncthreads();
}

typedef float f32x16 __attribute__((ext_vector_type(16)));
typedef short s16x4 __attribute__((ext_vector_type(4)));
__device__ __forceinline__ void attn_phase(LAS unsigned char* lds, const bf16_t* __restrict__ u, bf16_t* __restrict__ attn, const float* __restrict__ sinks, const float* __restrict__ qg, const float* __restrict__ kg, int G, int wv_) {
    int tid_ = wv_ * 64 + lane_id(); asm volatile("" : "+v"(tid_));
    const int tid = tid_, lane = tid & 63, wave = __builtin_amdgcn_readfirstlane(tid >> 6), r32 = lane & 31, hi = lane >> 5;
    u32x4 kreg[4], vreg[4];
#define ATT_LOAD(un_) do { const int kvh_ = (un_) & 1, t0_ = ((un_) >> 1) * 128; _Pragma("unroll") for (int it = 0; it < 4; ++it) { const int i = tid + it * NT, j = i >> 3, ch = i & 7; int tok = t0_ - 128 + j; tok = tok < 0 ? 0 : tok; \
        kreg[it] = *(const u32x4*)(u + (size_t)tok * IND + POOLD + QD + kvh_ * 64 + ch * 8); vreg[it] = *(const u32x4*)(u + (size_t)tok * IND + POOLD + QD + KVD + kvh_ * 64 + ch * 8); } } while (0)
    if ((int)blockIdx.x < (T / 128) * 2) ATT_LOAD((int)blockIdx.x);
    for (int un = blockIdx.x; un < (T / 128) * 2; un += G) {
        const int kvh = un & 1, blk = un >> 1, t0 = blk * 128; const bool first = (t0 % SEQ) == 0;
#pragma unroll
        for (int it = 0; it < 4; ++it) { const int i = tid + it * NT, j = i >> 3, ch = i & 7;
            u32x4 kk = kreg[it]; const u32x4 vv = vreg[it];
            {
                float f[8] = {bf2f(kk.x & 0xffffu), bf2f(kk.x >> 16), bf2f(kk.y & 0xffffu), bf2f(kk.y >> 16), bf2f(kk.z & 0xffffu), bf2f(kk.z >> 16), bf2f(kk.w & 0xffffu), bf2f(kk.w >> 16)};
                float ss = 0.f;
#pragma unroll
                for (int q = 0; q < 8; ++q) ss += f[q] * f[q];
                ss = sum8(ss);
                const float r = rsqrtf(ss * (1.f / 64.f) + EPS); const float* gp = kg + 8 * ch;
                kk.x = pk2(f[0] * r * gp[0], f[1] * r * gp[1]); kk.y = pk2(f[2] * r * gp[2], f[3] * r * gp[3]); kk.z = pk2(f[4] * r * gp[4], f[5] * r * gp[5]); kk.w = pk2(f[6] * r * gp[6], f[7] * r * gp[7]); }
            *(LAS u32x4*)(lds + j * 128 + ((ch ^ (j & 7)) * 16)) = kk;
            *(LAS u32x4*)(lds + 32768 + j * 128 + ch * 16) = vv; }
        if (un + G < (T / 128) * 2) ATT_LOAD(un + G);
        __syncthreads();
#pragma unroll 1
        for (int task = wave; task < 16; task += 8) {
            const int hq = task & 3, rb = task >> 2, h = kvh * 4 + hq; const int tq = t0 + 32 * rb + r32;
            const float slope2 = exp2f(-(float)(h + 1)) * LOG2E, sink2 = sinks[h] * LOG2E;
            bf16x8 qf[4];
            {
                u32x4 qr[4]; float ss = 0.f;
#pragma unroll
                for (int ds = 0; ds < 4; ++ds) { qr[ds] = *(const u32x4*)(u + (size_t)tq * IND + POOLD + h * 64 + 16 * ds + 8 * hi);
                    const float f[8] = {bf2f(qr[ds].x & 0xffffu), bf2f(qr[ds].x >> 16), bf2f(qr[ds].y & 0xffffu), bf2f(qr[ds].y >> 16), bf2f(qr[ds].z & 0xffffu), bf2f(qr[ds].z >> 16), bf2f(qr[ds].w & 0xffffu), bf2f(qr[ds].w >> 16)};
#pragma unroll
                    for (int q = 0; q < 8; ++q) ss += f[q] * f[q]; }
                ss = xsum32(ss);
                const float r = rsqrtf(ss * (1.f / 64.f) + EPS) * (0.125f * LOG2E);
#pragma unroll
                for (int ds = 0; ds < 4; ++ds) { const float* gp = qg + 16 * ds + 8 * hi;
                    const float f[8] = {bf2f(qr[ds].x & 0xffffu), bf2f(qr[ds].x >> 16), bf2f(qr[ds].y & 0xffffu), bf2f(qr[ds].y >> 16), bf2f(qr[ds].z & 0xffffu), bf2f(qr[ds].z >> 16), bf2f(qr[ds].w & 0xffffu), bf2f(qr[ds].w >> 16)};
                    u32x4 w; w.x = pk2(f[0] * r * gp[0], f[1] * r * gp[1]); w.y = pk2(f[2] * r * gp[2], f[3] * r * gp[3]); w.z = pk2(f[4] * r * gp[4], f[5] * r * gp[5]); w.w = pk2(f[6] * r * gp[6], f[7] * r * gp[7]);
                    qf[ds] = __builtin_bit_cast(bf16x8, w); } }
            f32x16 sc[5];
            const LAS unsigned char* kbase = lds + (32 * rb + r32) * 128;
            int kch[4];
#pragma unroll
            for (int ds = 0; ds < 4; ++ds) kch[ds] = ((2 * ds + hi) ^ (r32 & 7)) * 16;
#pragma unroll
            for (int tt = 0; tt < 5; ++tt) {
#pragma unroll
                for (int r = 0; r < 16; ++r) sc[tt][r] = 0.f;
#pragma unroll
                for (int ds = 0; ds < 4; ++ds) { const bf16x8 kf = *(const LAS bf16x8*)(kbase + kch[ds] + tt * 4096);
                    sc[tt] = __builtin_amdgcn_mfma_f32_32x32x16_bf16(kf, qf[ds], sc[tt], 0, 0, 0); } }
            float mx = -INFINITY;
            int lq = r32 - 4 * hi, lf = 32 * rb + 4 * hi; asm volatile("" : "+v"(lq), "+v"(lf));
            const float lbase = slope2 * (float)(128 + lq);
#pragma unroll
            for (int tt = 0; tt < 5; ++tt)
#pragma unroll
                for (int r = 0; r < 16; ++r) { const int c0 = (r & 3) + 8 * (r >> 2), cc = 32 * tt + c0;
                    float v = fmaf(slope2, (float)cc, sc[tt][r] - lbase);
                    bool ok = true; if (tt == 0) ok = c0 > lq; if (tt == 4) ok = c0 <= lq;
                    if (first && (lf < 128 - cc)) ok = false;
                    v = ok ? v : -INFINITY; sc[tt][r] = v; mx = fmaxf(mx, v); }
            mx = fmaxf(xmax32(mx), sink2);
            float ls = 0.f;
#pragma unroll
            for (int tt = 0; tt < 5; ++tt)
#pragma unroll
                for (int r = 0; r < 16; ++r) { const float p = __builtin_amdgcn_exp2f(sc[tt][r] - mx); sc[tt][r] = p; ls += p; }
            ls = xsum32(ls) + __builtin_amdgcn_exp2f(sink2 - mx);
            const float inv = 1.f / ls;
            f32x16 o[2];
#pragma unroll
            for (int db = 0; db < 2; ++db)
#pragma unroll
                for (int r = 0; r < 16; ++r) o[db][r] = 0.f;
            const int g4 = lane >> 4, i16 = lane & 15;
            const LAS unsigned char* vbase = lds + 32768 + (32 * rb + 4 * (g4 >> 1) + (i16 >> 2)) * 128 + (16 * (g4 & 1) + 4 * (i16 & 3)) * 2;
#pragma unroll
            for (int tt = 0; tt < 5; ++tt)
#pragma unroll
                for (int s2 = 0; s2 < 2; ++s2) {
                    u32x4 pw; pw.x = cvt_pk_bf16(sc[tt][8 * s2 + 0], sc[tt][8 * s2 + 1]); pw.y = cvt_pk_bf16(sc[tt][8 * s2 + 2], sc[tt][8 * s2 + 3]);
                    pw.z = cvt_pk_bf16(sc[tt][8 * s2 + 4], sc[tt][8 * s2 + 5]); pw.w = cvt_pk_bf16(sc[tt][8 * s2 + 6], sc[tt][8 * s2 + 7]);
                    const bf16x8 pb = __builtin_bit_cast(bf16x8, pw);
#pragma unroll
                    for (int db = 0; db < 2; ++db) {
                        const s16x4 lo = __builtin_bit_cast(s16x4, __builtin_amdgcn_ds_read_tr16_b64_v4i16((LAS s16x4*)(vbase + tt * 4096 + s2 * 2048 + db * 64)));
                        const s16x4 hi4 = __builtin_bit_cast(s16x4, __builtin_amdgcn_ds_read_tr16_b64_v4i16((LAS s16x4*)(vbase + tt * 4096 + s2 * 2048 + 1024 + db * 64)));
                        const bf16x8 vf = (bf16x8){lo[0], lo[1], lo[2], lo[3], hi4[0], hi4[1], hi4[2], hi4[3]};
                        o[db] = __builtin_amdgcn_mfma_f32_32x32x16_bf16(vf, pb, o[db], 0, 0, 0); } }
            bf16_t* orow = attn + (size_t)tq * QD + h * 64 + 4 * hi;
#pragma unroll
            for (int db = 0; db < 2; ++db)
#pragma unroll
                for (int gq = 0; gq < 4; ++gq) { u32x2 w; w.x = cvt_pk_bf16(o[db][4 * gq + 0] * inv, o[db][4 * gq + 1] * inv); w.y = cvt_pk_bf16(o[db][4 * gq + 2] * inv, o[db][4 * gq + 3] * inv);
                    *(u32x2*)(orow + 32 * db + 8 * gq) = w; }
        }
        __syncthreads();
    }
#undef ATT_LOAD
}

__global__ void __launch_bounds__(NT, 2) mk_fwd(P a) {
    cg::grid_group grid = cg::this_grid();
    extern __shared__ __attribute__((aligned(16))) unsigned char lds[];
    LAS unsigned char* lds3 = (LAS unsigned char*)lds;
    const int wave_s = __builtin_amdgcn_readfirstlane((int)threadIdx.x >> 6);
    int tid, half, vt, tx, ty, lane, wave; float (*As)[68]; float (*Bs)[64]; size_t gtid;
#define REFRESH() do { tid = wave_s * 64 + lane_id(); asm volatile("" : "+v"(tid)); half = tid >> 8; vt = tid & 255; tx = vt & 15; ty = vt >> 4; lane = tid & 63; wave = tid >> 6; \
        As = (float (*)[68])(lds + half * 8704); Bs = (float (*)[64])(lds + half * 8704 + 4352); gtid = (size_t)blockIdx.x * NT + tid; } while (0)
    REFRESH();
    if (tid < 2) ((volatile LAS unsigned*)(lds3 + LDS_TAB + 1024))[tid] = 0u;
    __syncthreads();
    const XcdBarrier xbar = xcd_barrier_post((unsigned*)(a.ws + C_BAR), (volatile LAS unsigned*)(lds3 + LDS_TAB + 1024), wave_s == 0);
    const int G = gridDim.x; const size_t gthreads = (size_t)G * NT; const int nwaves = G * (NT / 64);
#define Wcat ((bf16_t*)(a.ws + W_CAT))
#define Wpp ((bf16_t*)(a.ws + W_PP))
#define Wmix ((bf16_t*)(a.ws + W_MIX))
#define Wa_ ((bf16_t*)(a.ws + W_A))
#define Wb_ ((bf16_t*)(a.ws + W_B))
#define Wout ((bf16_t*)(a.ws + W_OUT))
#define Wsh ((bf16_t*)(a.ws + W_SH))
#define Wr ((bf16_t*)(a.ws + W_R))
#define Wsd ((bf16_t*)(a.ws + W_SD))
#define Wpg ((bf16_t*)(a.ws + W_PG))
#define Wexp ((bf16_t*)(a.ws + W_EXP))
#define Wed ((bf16_t*)(a.ws + W_ED))
#define rsspp ((float*)(a.ws + C_RSPP))
#define rss2 ((float*)(a.ws + C_RS2))
#define rss3 ((float*)(a.ws + C_RS3))
#define cntblk ((int*)(a.ws + C_CNTBLK))
#define sel ((int*)(a.ws + C_SEL))
#define tokl ((int*)(a.ws + C_TOKL))
#define rinfo ((int2*)(a.ws + C_RINFO))
#define wl ((float*)(a.ws + LOGITS))
#define Yb ((unsigned char*)(a.ws + YB))
#define wts ((float*)(a.ws + C_WTS))
#define ppb ((bf16_t*)(a.ws + PP))
#define hb ((bf16_t*)(a.ws + HB))
#define pb ((bf16_t*)(a.ws + PB))
#define ub ((bf16_t*)(a.ws + UB))
#define gb ((bf16_t*)(a.ws + GB))
#define poolb ((bf16_t*)(a.ws + POOLB))
#define logits ((float*)(a.ws + LOGITS))
#define attnb ((bf16_t*)(a.ws + HB))
#define mixb ((bf16_t*)(a.ws + HB + 32 * MiB))
#define mergedb ((bf16_t*)(a.ws + UB))
#define hg2 ((bf16_t*)(out))
#define hg3 ((bf16_t*)(a.ws + W_EXP))
#define actsh ((bf16_t*)(a.ws + ACTSH))
#define actr ((bf16_t*)(a.ws + ACTR))
#define out (a.out)
    {
        LAS float* scr = (LAS float*)(lds3 + wave * 16384);
        const int gw = blockIdx.x * (NT / 64) + wave;
        constexpr int I_IN = 16 * 40, I_G = 16 * 64, I_PP = 4 * 32, I_AB = 8 * 32, I_SQ = 16 * 32, I_GU = 16 * 8, I_R = 16 * 2, I_SD = 4 * 32;
        constexpr int I_E = NE * 128;
        constexpr int NITEMS = I_IN + I_G + I_PP + 2 * I_AB + 2 * I_SQ + 2 * I_GU + I_R + I_SD + 3 * I_E;
        auto decode = [&](int it) -> TItem { int r = it;
            if (r < I_IN) return ti_plain(a.w_in, D, IND, Wcat, 0, r); r -= I_IN;
            if (r < I_G) return ti_gate(a.w_gate, Wcat, r); r -= I_G;
            if (r < I_PP) return ti_plain(a.w_pp, PLE, D, Wpp, 0, r); r -= I_PP;
            if (r < I_AB) return ti_plain(a.w_a, 512, D, Wa_, 0, r); r -= I_AB;
            if (r < I_AB) return ti_plain(a.w_b, 512, D, Wb_, 0, r); r -= I_AB;
            if (r < I_SQ) return ti_plain(a.w_out, D, D, Wout, 0, r); r -= I_SQ;
            if (r < I_SQ) return ti_plain(a.w_pg, D, D, Wpg, 0, r, a.g_ple); r -= I_SQ;
            if (r < I_GU) return ti_gu(a.w_sg, Wsh, 0, r, a.g_ffn); r -= I_GU;
            if (r < I_GU) return ti_gu(a.w_su, Wsh, 1, r, a.g_ffn); r -= I_GU;
            if (r < I_R) return ti_plain(a.w_router, D, NE, Wr, 0, r, a.g_ffn); r -= I_R;
            if (r < I_SD) return ti_plain(a.w_sd, SD, D, Wsd, 0, r); r -= I_SD;
            if (r < I_E) { const int e = r >> 7; return ti_gu(a.w_eg + (size_t)e * D * ED, Wexp + (size_t)e * 512 * D, 0, r & 127, a.g_ffn); } r -= I_E;
            if (r < I_E) { const int e = r >> 7; return ti_gu(a.w_eu + (size_t)e * D * ED, Wexp + (size_t)e * 512 * D, 1, r & 127, a.g_ffn); } r -= I_E;
            { const int e = r >> 7; return ti_plain(a.w_ed + (size_t)e * ED * D, ED, D, Wed + (size_t)e * D * ED, 0, r & 127); } };
        if (gw < NITEMS) {
            TItem cur_ = decode(gw); f32x4 va[8], vb[8]; ti_load(cur_, va, lane);
            for (int it = gw; it < NITEMS; it += 2 * nwaves) {
                const int i1 = it + nwaves, i2 = it + 2 * nwaves; TItem n1 = cur_, n2 = cur_;
                if (i1 < NITEMS) { n1 = decode(i1); ti_load(n1, vb, lane); }
                ti_finish(cur_, va, scr, lane);
                if (i1 < NITEMS) { if (i2 < NITEMS) { n2 = decode(i2); ti_load(n2, va, lane); } ti_finish(n1, vb, scr, lane); cur_ = n2; }
            }
        }
        for (size_t i = gtid; i < (size_t)2 * 256 * 256; i += gthreads) { const int pn = (int)(i >> 16), n = (int)((i >> 8) & 255), k = (int)(i & 255);
            const float v = ((n >> 7) == (k >> 7)) ? a.w_pool_mix[(size_t)(2 * pn + (n >> 7)) * 128 * 128 + (size_t)(k & 127) * 128 + (n & 127)] * a.pool_scale[256 * pn + n] : 0.f;
            Wmix[i] = (bf16_t)f2bf(v); }
        for (size_t i = gtid; i < (size_t)192 * D / 8; i += gthreads) *((u32x4*)(Wr + (size_t)64 * D) + i) = (u32x4){0u, 0u, 0u, 0u};
        for (int m0 = gw; m0 < T; m0 += 2 * nwaves) {
            f32x4 v[2][4], pv[2]; float sq[2];
#pragma unroll
            for (int rr = 0; rr < 2; ++rr) { const int m = (m0 + rr * nwaves < T) ? m0 + rr * nwaves : m0; const f32x4* xr = (const f32x4*)(a.x + (size_t)m * D) + lane;
#pragma unroll
                for (int j = 0; j < 4; ++j) v[rr][j] = xr[64 * j];
                pv[rr] = *((const f32x4*)(a.p + (size_t)m * PLE) + lane); }
#pragma unroll
            for (int rr = 0; rr < 2; ++rr) { float s_ = 0.f;
#pragma unroll
                for (int j = 0; j < 4; ++j) s_ += (v[rr][j].x * v[rr][j].x + v[rr][j].y * v[rr][j].y) + (v[rr][j].z * v[rr][j].z + v[rr][j].w * v[rr][j].w);
                sq[rr] = wave_sum(s_); }
#pragma unroll
            for (int rr = 0; rr < 2; ++rr) { const int m = m0 + rr * nwaves; if (m < T) { const float r = rsqrtf(sq[rr] * (1.f / D) + EPS);
                u32x2* o8 = (u32x2*)(hb + (size_t)m * D) + lane;
#pragma unroll
                for (int j = 0; j < 4; ++j) { const f32x4 gg = *((const f32x4*)a.g_mix + lane + 64 * j); u32x2 w; w.x = pk2(v[rr][j].x * r * gg.x, v[rr][j].y * r * gg.y); w.y = pk2(v[rr][j].z * r * gg.z, v[rr][j].w * r * gg.w); o8[64 * j] = w; }
                u32x2 w; w.x = pk2(pv[rr].x, pv[rr].y); w.y = pk2(pv[rr].z, pv[rr].w); *((u32x2*)(pb + (size_t)m * PLE) + lane) = w; } }
        }
        for (size_t i = gtid; i < (size_t)T; i += gthreads) { rsspp[i] = 0.f; rss2[i] = 0.f; rss3[i] = 0.f; }
    }
    if (gridDim.x == 0x7fffffffu) grid.sync();
    xcd_barrier(xbar, tid); REFRESH();
    {
        pg8::Cfg g1{(unsigned)D * 2u, (unsigned)D * 2u, D};
        pg8::DenseSched S1{T / 256, NCAT / 256, G, (int)blockIdx.x, (const char*)hb, (const char*)Wcat, (size_t)256 * D * 2, (size_t)256 * D * 2};
        EpiG1 E1{ub, gb, a.b_gate};
        pg8::gemm_phase<EpiG1, pg8::DenseSched, false>(lds3, g1, S1, E1, wave_s);
        pg8::Cfg g2{(unsigned)PLE * 2u, (unsigned)PLE * 2u, PLE};
        PPSched S2{G, (int)blockIdx.x, (const char*)pb, (const char*)Wpp};
        EpiPP E2{ppb, rsspp};
        pg8::gemm_phase<EpiPP, PPSched, false>(lds3, g2, S2, E2, wave_s);
    }
    xcd_barrier(xbar, tid); REFRESH();
    for (int i = 0;; ++i) { int pm, pn; if (!pg8::static_tile(i, G, (int)blockIdx.x, T / 256, 2, pm, pn)) break;
        const int ch = tid & 31, rg = tid >> 5, col = 256 * pn + 8 * ch, w = 2 << (col >> 7), t0 = 256 * pm + 16 * rg, pos0 = t0 % SEQ;
        const bf16_t* rp0 = ub + (size_t)t0 * IND + col; float sw[8];
#pragma unroll
        for (int q = 0; q < 8; ++q) sw[q] = 0.f;
        { u32x4 pv[15];
#pragma unroll
          for (int k = 1; k < 16; ++k) pv[k - 1] = *(const u32x4*)(rp0 - (size_t)((k < w && k <= pos0) ? k : 0) * IND);
#pragma unroll
          for (int k = 1; k < 16; ++k) { const float mk = (k < w && k <= pos0) ? 1.f : 0.f; const u32x4 p4 = pv[k - 1];
              sw[0] += mk * bf2f(p4.x & 0xffffu); sw[1] += mk * bf2f(p4.x >> 16); sw[2] += mk * bf2f(p4.y & 0xffffu); sw[3] += mk * bf2f(p4.y >> 16);
              sw[4] += mk * bf2f(p4.z & 0xffffu); sw[5] += mk * bf2f(p4.z >> 16); sw[6] += mk * bf2f(p4.w & 0xffffu); sw[7] += mk * bf2f(p4.w >> 16); } }
#pragma unroll 1
        for (int b4 = 0; b4 < 4; ++b4) { u32x4 nw[4], od[4];
#pragma unroll
            for (int j = 0; j < 4; ++j) { const int r = 4 * b4 + j; nw[j] = *(const u32x4*)(rp0 + (size_t)r * IND);
                od[j] = *(const u32x4*)(rp0 + (size_t)((pos0 + r >= w - 1) ? r - (w - 1) : r) * IND); }
#pragma unroll
            for (int j = 0; j < 4; ++j) { const int r = 4 * b4 + j; const int cn = pos0 + r + 1 < w ? pos0 + r + 1 : w; const float ic = 1.f / (float)cn, mo = (pos0 + r >= w - 1) ? 1.f : 0.f;
                const float c8[8] = {bf2f(nw[j].x & 0xffffu), bf2f(nw[j].x >> 16), bf2f(nw[j].y & 0xffffu), bf2f(nw[j].y >> 16), bf2f(nw[j].z & 0xffffu), bf2f(nw[j].z >> 16), bf2f(nw[j].w & 0xffffu), bf2f(nw[j].w >> 16)};
                const float o8[8] = {bf2f(od[j].x & 0xffffu), bf2f(od[j].x >> 16), bf2f(od[j].y & 0xffffu), bf2f(od[j].y >> 16), bf2f(od[j].z & 0xffffu), bf2f(od[j].z >> 16), bf2f(od[j].w & 0xffffu), bf2f(od[j].w >> 16)};
                float e8[8];
#pragma unroll
                for (int q = 0; q < 8; ++q) { sw[q] += c8[q]; e8[q] = sw[q] * ic - c8[q]; sw[q] -= mo * o8[q]; }
                u32x4 o; o.x = pk2(e8[0], e8[1]); o.y = pk2(e8[2], e8[3]); o.z = pk2(e8[4], e8[5]); o.w = pk2(e8[6], e8[7]);
                *(u32x4*)(poolb + (size_t)(t0 + r) * POOLD + col) = o; } } }
    asm volatile("s_waitcnt vmcnt(0)" ::: "memory");
    __syncthreads();
    {
        pg8::Cfg gm{(unsigned)POOLD * 2u, 512u, 256};
        MixSched Sm{G, (int)blockIdx.x, (const char*)poolb, (const char*)Wmix};
        EpiBf16Plain Em{mixb, POOLD};
        pg8::gemm_phase<EpiBf16Plain, MixSched, false>(lds3, gm, Sm, Em, wave_s);
    }
    REFRESH();
    attn_phase(lds3, ub, attnb, a.sinks, a.q_gain, a.k_gain, G, wave_s);
    xcd_barrier(xbar, tid); REFRESH();
    {
        pg8::Cfg g4{1024u, 1024u, 512};
        MergedSched S4{G, (int)blockIdx.x, (const char*)mixb, (const char*)attnb, (const char*)Wa_, (const char*)Wb_};
        EpiMerged E4{gb, mergedb};
        pg8::gemm_phase<EpiMerged, MergedSched, false>(lds3, g4, S4, E4, wave_s);
    }
    xcd_barrier(xbar, tid); REFRESH();
    {
        pg8::Cfg g5{(unsigned)D * 2u, (unsigned)D * 2u, D};
        pg8::DenseSched S5{T / 256, D / 256, G, (int)blockIdx.x, (const char*)mergedb, (const char*)Wout, (size_t)256 * D * 2, (size_t)256 * D * 2};
        EpiResid E5{a.x, hg2, rss2};
        pg8::gemm_phase<EpiResid, pg8::DenseSched, false>(lds3, g5, S5, E5, wave_s);
    }
    xcd_barrier(xbar, tid); REFRESH();
    {
        pg8::Cfg g6{(unsigned)D * 2u, (unsigned)D * 2u, D};
        P6Sched S6{G, (int)blockIdx.x, (const char*)hg2, (const char*)Wsh};
        EpiShared E6{actsh, logits, rss2};
        pg8::gemm_phase<EpiShared, P6Sched, false>(lds3, g6, S6, E6, wave_s);
    }
    REFRESH();
    if (G != 256) { xcd_barrier(xbar, tid); REFRESH(); }
    __syncthreads();
    for (int cpair = blockIdx.x; cpair < NCHUNK / 2; cpair += G) {
        float (*C)[65] = (float (*)[65])(lds + (wave & 3) * 16640);
        int* cw = (int*)(lds + 4 * 16640);
        const int ch = cpair * 2 + ((wave >> 1) & 1);
        int idx[8], rk[8]; float sv[8]; const int t = ch * 128 + (wave & 1) * 64 + lane;
        if (wave < 4) {
            { const f32x4* lg4 = (const f32x4*)(logits + (size_t)(t - lane) * 64); const f32x4 b4 = *((const f32x4*)a.router_bias + (lane & 15)); f32x4 lv[16];
#pragma unroll
              for (int i = 0; i < 16; ++i) lv[i] = lg4[i * 64 + lane];
#pragma unroll
              for (int i = 0; i < 16; ++i) { float* cr = &C[4 * i + (lane >> 4)][4 * (lane & 15)];
#pragma unroll
                  for (int q = 0; q < 4; ++q) cr[q] = 1.f / (1.f + expf(-lv[i][q])) + b4[q]; } }
            float gs[8];
#pragma unroll
            for (int g = 0; g < 8; ++g) { float m1 = -INFINITY, m2 = -INFINITY;
#pragma unroll
                for (int j = 0; j < 8; ++j) { const float v = C[lane][g * 8 + j]; if (v > m1) { m2 = m1; m1 = v; } else if (v > m2) m2 = v; }
                gs[g] = m1 + m2; }
            unsigned gsel = 0u;
#pragma unroll
            for (int it = 0; it < 4; ++it) { float best = -INFINITY; int bi = 0;
#pragma unroll
                for (int g = 0; g < 8; ++g) { const bool fr_ = !((gsel >> g) & 1u); if (fr_ && gs[g] > best) { best = gs[g]; bi = g; } }
                gsel |= 1u << bi; }
            unsigned long long chosen = 0ull; float wsum = 0.f;
#pragma unroll
            for (int g = 0; g < 8; ++g) if (!((gsel >> g) & 1u)) {
#pragma unroll
                for (int j = 0; j < 8; ++j) C[lane][g * 8 + j] = -INFINITY; }
#pragma unroll
            for (int k = 0; k < 8; ++k) { float best = -INFINITY; int bi = 0;
#pragma unroll 8
                for (int e = 0; e < 64; ++e) { const float v = C[lane][e]; if (v > best) { best = v; bi = e; } }
                C[lane][bi] = -INFINITY; chosen |= 1ull << bi; idx[k] = bi; sv[k] = 1.f / (1.f + expf(-logits[(size_t)t * 64 + bi])); wsum += sv[k]; rk[k] = 0; }
#pragma unroll
            for (int k = 0; k < 8; ++k) sv[k] = sv[k] / (wsum + 1e-20f) * 2.5f;
#pragma unroll 1
            for (int e = 0; e < 64; ++e) { const bool chs = (chosen >> e) & 1ull; const unsigned long long mm = __ballot(chs); const int r = __popcll(mm & ((1ull << lane) - 1ull));
                if (lane == 0) cw[wave * 64 + e] = __popcll(mm);
#pragma unroll
                for (int k = 0; k < 8; ++k) if (idx[k] == e) rk[k] = r; }
        }
        __syncthreads();
        if (wave < 4) {
#pragma unroll
            for (int k = 0; k < 8; ++k) { const int r = rk[k] + ((wave & 1) ? cw[(wave - 1) * 64 + idx[k]] : 0); sel[(size_t)t * 8 + k] = idx[k] | (r << 8); wts[(size_t)t * 8 + k] = sv[k]; }
            if ((wave & 1) == 0) cntblk[ch * 64 + lane] = cw[wave * 64 + lane] + cw[(wave + 1) * 64 + lane];
        }
        __syncthreads();
    }
    xcd_barrier(xbar, tid); REFRESH();
    {
        int* tot = (int*)(lds + 0); int* pst = (int*)(lds + 512); int* base = (int*)(lds + 1024); LAS int* mts = (LAS int*)(lds3 + LDS_TAB);
        int* part = (int*)(lds + 2048);
        LAS int* lo_t = (LAS int*)(lds3 + LDS_TAB + LT_LO); LAS int* tst_t = (LAS int*)(lds3 + LDS_TAB + LT_TST);
        LAS unsigned char* t2e7 = lds3 + LDS_TAB + LT_T2E7; LAS unsigned char* t2e8 = lds3 + LDS_TAB + LT_T2E8;
        const int e_ = tid & 63, pt = tid >> 6; const int ch0 = blockIdx.x;
        { int sr[NROUND + 1];
#pragma unroll
          for (int r = 0; r <= NROUND; ++r) sr[r] = 0;
#pragma unroll 4
          for (int c2 = pt; c2 < NCHUNK; c2 += 8) { const int v = cntblk[c2 * 64 + e_]; sr[0] += v; sr[NROUND] += (c2 < ch0) ? v : 0;
#pragma unroll
              for (int r = 1; r < NROUND; ++r) sr[r] += (c2 < r * (NCHUNK / NROUND)) ? v : 0; }
#pragma unroll
          for (int r = 0; r <= NROUND; ++r) part[r * 512 + pt * 64 + e_] = sr[r]; }
        __syncthreads();
        if (tid < 64) {
#pragma unroll
            for (int r = 0; r <= NROUND; ++r) { int sm = 0;
#pragma unroll
                for (int q = 0; q < 8; ++q) sm += part[r * 512 + q * 64 + tid];
                if (r == 0) tot[tid] = sm; else if (r == NROUND) base[tid] = sm; else lo_t[r * 64 + tid] = sm; } }
        __syncthreads();
        if (tid < 64) { int p = 0;
#pragma unroll 8
            for (int e = 0; e < 64; ++e) { const int pd = (tot[e] + 255) & ~255; p += (e < tid) ? pd : 0; }
            pst[tid] = p; mts[tid] = p >> 8;
            if (tid == 63) { const int pe = p + ((tot[63] + 255) & ~255); pst[64] = pe; mts[64] = pe >> 8; mts[65] = pe >> 8; } }
        __syncthreads();
        if (tid < 64) { const int p0 = pst[tid]; lo_t[tid] = p0;
#pragma unroll
            for (int r = 1; r < NROUND; ++r) lo_t[r * 64 + tid] += p0;
            lo_t[NROUND * 64 + tid] = p0 + tot[tid];
            for (int j = mts[tid]; j < mts[tid + 1]; ++j) t2e7[j] = (unsigned char)tid; }
        __syncthreads();
        if (wave < NROUND) { LAS int* cb_t = (LAS int*)(lds3 + LDS_TAB + LT_CB); const int r_ = wave;
            int m = 0, cacc = 0, mt = 0, ct = 0;
#pragma unroll 8
            for (int e = 0; e < 64; ++e) { const int c_ = lo_t[(r_ + 1) * 64 + e] - lo_t[r_ * 64 + e], n_ = (c_ + 255) >> 8; m += (e < lane) ? n_ : 0; cacc += (e < lane) ? c_ : 0; mt += n_; ct += c_; }
            tst_t[r_ * 65 + lane] = m; cb_t[r_ * 64 + lane] = cacc; if (lane == 0) tst_t[r_ * 65 + 64] = mt;
            const int nt_ = (lo_t[(r_ + 1) * 64 + lane] - lo_t[r_ * 64 + lane] + 255) >> 8;
            for (int j = 0; j < nt_; ++j) t2e8[r_ * T2S + (m + j)] = (unsigned char)lane; }
        __syncthreads();
        if ((int)blockIdx.x < 64 && tid < 256) { const int e = blockIdx.x; const int j = tot[e] + tid; if (j < ((tot[e] + 255) & ~255)) { tokl[pst[e] + j] = -1; rinfo[pst[e] + j] = make_int2(-1, 0); wl[pst[e] + j] = 0.f; } }
        for (int ch = blockIdx.x; ch < NCHUNK; ch += G) {
            if (ch != ch0) {
                __syncthreads();
                if (tid < 64) { int sum = 0;
#pragma unroll 4
                    for (int c2 = 0; c2 < ch; ++c2) sum += cntblk[c2 * 64 + tid];
                    base[tid] = sum; }
                __syncthreads();
            }
            { const int t = ch * 128 + (tid & 127), rr_ = t / TR; const float rs_ = rsqrtf(rss2[t] * (1.f / D) + EPS);
#pragma unroll
                for (int kk = 0; kk < 2; ++kk) { const int k = 2 * (tid >> 7) + kk; const int sl = sel[(size_t)t * 8 + k]; const int e_k = sl & 255, pos = pst[e_k] + base[e_k] + (sl >> 8);
                    sel[(size_t)t * 8 + k] = ((const LAS int*)(lds3 + LDS_TAB + LT_CB))[rr_ * 64 + e_k] + (pos - lo_t[rr_ * 64 + e_k]);
                    tokl[pos] = t * 8 + k; rinfo[pos] = make_int2(t * 9 + k, __float_as_int(rs_)); wl[pos] = wts[(size_t)t * 8 + k]; } }
        }
    }
    xcd_barrier(xbar, tid); REFRESH();
    const int ntr = ((LAS int*)(lds3 + LDS_TAB))[64];
    {
        pg8::Cfg g7{(unsigned)D * 2u, (unsigned)D * 2u, D};
        RoutedUpSched S7{G, (int)blockIdx.x, ntr, (const LAS unsigned char*)(lds3 + LDS_TAB + LT_T2E7), tokl, (const char*)hg2, (const char*)Wexp};
        EpiRoutedUp E7{actr, rinfo, wl};
        pg8::gemm_phase<EpiRoutedUp, RoutedUpSched, true>(lds3, g7, S7, E7, wave_s);
    }
    xcd_barrier(xbar, tid); REFRESH();
#pragma unroll 1
    for (int q = 0; q <= NROUND; ++q) {
#pragma unroll 1
        for (int part2 = 0; part2 < 2; ++part2) {
            const bool do_down = (part2 == (int)(blockIdx.x & 1));
            if (do_down) { if (q < NROUND) {
                pg8::Cfg g8{(unsigned)ED * 2u, (unsigned)ED * 2u, ED};
                DownSched S8{G, (int)blockIdx.x, q, (const LAS int*)(lds3 + LDS_TAB + LT_LO), (const LAS int*)(lds3 + LDS_TAB + LT_TST), (const LAS unsigned char*)(lds3 + LDS_TAB + LT_T2E8), (const LAS int*)(lds3 + LDS_TAB + LT_CB), (const char*)actr, (const char*)actsh, (const char*)Wed, (const char*)Wsd};
                EpiDown E8{Yb + (size_t)(q & 1) * TR * 9 * 1024};
                pg8::gemm_phase<EpiDown, DownSched, false>(lds3, g8, S8, E8, wave_s);
                REFRESH(); }
            } else if (q > 0) { const int qc = q - 1;
                char* wsl = a.ws; float* outl = out; asm volatile("" : "+s"(wsl), "+s"(outl));
                const unsigned char* Yc = (const unsigned char*)(wsl + YB) + (size_t)(qc & 1) * TR * 9 * 1024; const int* sel_l = (const int*)(wsl + C_SEL); const bf16_t* x1l = (const bf16_t*)outl; bf16_t* x2l = (bf16_t*)(wsl + W_EXP); float* rss3l = (float*)(wsl + C_RS3);
                int rem = 0; if (q < NROUND) rem = ((((const LAS int*)(lds3 + LDS_TAB + LT_TST))[q * 65 + 64] + TR / 256) * 4) % G;
                if (rem > G / 2) rem = 0;
                const int li = (int)blockIdx.x - rem, nlw = (G - rem) * (NT / 64);
                if (li >= 0)
                for (int tl0 = li * (NT / 64) + wave; tl0 < TR; tl0 += 2 * nlw) { const int nwaves_c = nlw; const int col = lane * 16;
                    u32x4 y[2][9], xa[2], xb_[2];
#pragma unroll
                    for (int u2 = 0; u2 < 2; ++u2) { const int tl_ = (tl0 + u2 * nwaves_c < TR) ? tl0 + u2 * nwaves_c : tl0; const int t = qc * TR + tl_;
                        const bf16_t* xi = x1l + (size_t)t * D + col;
#pragma unroll
                        for (int k = 0; k < 8; ++k) y[u2][k] = *(const u32x4*)(Yc + (size_t)sel_l[(size_t)t * 8 + k] * 1024 + col);
                        y[u2][8] = *(const u32x4*)(Yc + (size_t)(8 * TR + tl_) * 1024 + col);
                        xa[u2] = *(const u32x4*)xi; xb_[u2] = *(const u32x4*)(xi + 8); }
#pragma unroll
                    for (int u2 = 0; u2 < 2; ++u2) { const int tl_ = tl0 + u2 * nwaves_c; if (tl_ < TR) { const int t = qc * TR + tl_;
                        f32x4 v[4];
                        v[0] = (f32x4){bf2f(xa[u2].x & 0xffffu), bf2f(xa[u2].x >> 16), bf2f(xa[u2].y & 0xffffu), bf2f(xa[u2].y >> 16)}; v[1] = (f32x4){bf2f(xa[u2].z & 0xffffu), bf2f(xa[u2].z >> 16), bf2f(xa[u2].w & 0xffffu), bf2f(xa[u2].w >> 16)};
                        v[2] = (f32x4){bf2f(xb_[u2].x & 0xffffu), bf2f(xb_[u2].x >> 16), bf2f(xb_[u2].y & 0xffffu), bf2f(xb_[u2].y >> 16)}; v[3] = (f32x4){bf2f(xb_[u2].z & 0xffffu), bf2f(xb_[u2].z >> 16), bf2f(xb_[u2].w & 0xffffu), bf2f(xb_[u2].w >> 16)};
#pragma unroll
                        for (int k = 0; k < 9; ++k)
#pragma unroll
                            for (int j = 0; j < 4; ++j) { const f32x2 lo2 = __builtin_amdgcn_cvt_pk_f32_fp8((int)y[u2][k][j], false), hi2 = __builtin_amdgcn_cvt_pk_f32_fp8((int)y[u2][k][j], true);
                                v[j][0] += lo2.x; v[j][1] += lo2.y; v[j][2] += hi2.x; v[j][3] += hi2.y; }
                        float ss = 0.f; u32x4 w0, w1;
#pragma unroll
                        for (int j = 0; j < 4; ++j) { const unsigned p0 = pk2(v[j][0], v[j][1]), p1 = pk2(v[j][2], v[j][3]);
                            if (j == 0) { w0.x = p0; w0.y = p1; } else if (j == 1) { w0.z = p0; w0.w = p1; } else if (j == 2) { w1.x = p0; w1.y = p1; } else { w1.z = p0; w1.w = p1; }
                            ss += (v[j][0] * v[j][0] + v[j][1] * v[j][1]) + (v[j][2] * v[j][2] + v[j][3] * v[j][3]); }
                        *(u32x4*)(x2l + (size_t)t * D + col) = w0; *(u32x4*)(x2l + (size_t)t * D + col + 8) = w1;
                        ss = wave_sum(ss);
                        if (lane == 0) rss3l[t] = ss; } }
                }
            }
        }
        xcd_barrier(xbar, tid); REFRESH();
    }
    {
        pg8::Cfg g9{(unsigned)D * 2u, (unsigned)D * 2u, D};
        pg8::DenseSched S9{T / 256, D / 256, G, (int)blockIdx.x, (const char*)hg3, (const char*)Wpg, (size_t)256 * D * 2, (size_t)256 * D * 2};
        EpiFinal E9{out, hg3, ppb, rss3, rsspp, a.g_post};
        pg8::gemm_phase<EpiFinal, pg8::DenseSched, false>(lds3, g9, S9, E9, wave_s);
    }
}
#undef Wcat
#undef Wpp
#undef Wmix
#undef Wa_
#undef Wb_
#undef Wout
#undef Wsh
#undef Wr
#undef Wsd
#undef Wpg
#undef Wexp
#undef Wed
#undef rsspp
#undef rss2
#undef rss3
#undef cntblk
#undef sel
#undef tokl
#undef rinfo
#undef wl
#undef Yb
#undef wts
#undef ppb
#undef hb
#undef pb
#undef ub
#undef gb
#undef poolb
#undef logits
#undef attnb
#undef mixb
#undef mergedb
#undef hg2
#undef hg3
#undef actsh
#undef actr
#undef out
}

extern "C" void kernel_launch(void* const* d_in, const int* in_sizes, int n_in, void* d_out, int out_size, void* d_ws, size_t ws_size, hipStream_t stream) {
    using namespace mk;
    static int grid_blocks = 0;
    constexpr size_t LDSB = 147456;
    if (!grid_blocks) {
        int dev = 0, cus = 0, per_cu = 0;
        (void)hipGetDevice(&dev); (void)hipDeviceGetAttribute(&cus, hipDeviceAttributeMultiprocessorCount, dev);
        (void)hipFuncSetAttribute((const void*)mk_fwd, hipFuncAttributeMaxDynamicSharedMemorySize, (int)LDSB);
        (void)hipOccupancyMaxActiveBlocksPerMultiprocessor(&per_cu, (const void*)mk_fwd, NT, LDSB);
        if (per_cu < 1) { fprintf(stderr, "occupancy query says %d blocks per CU\n", per_cu); }
        grid_blocks = cus;
    }
    if (ws_size < (size_t)512 * MiB) { fprintf(stderr, "ws too small: %zu\n", ws_size); return; }
    P a{};
    a.x = (const float*)d_in[0]; a.p = (const float*)d_in[1]; a.g_mix = (const float*)d_in[2]; a.w_in = (const float*)d_in[3]; a.w_pool_mix = (const float*)d_in[4];
    a.pool_scale = (const float*)d_in[5]; a.w_a = (const float*)d_in[6]; a.q_gain = (const float*)d_in[7]; a.k_gain = (const float*)d_in[8]; a.sinks = (const float*)d_in[9];
    a.w_b = (const float*)d_in[10]; a.w_gate = (const float*)d_in[11]; a.b_gate = (const float*)d_in[12]; a.w_out = (const float*)d_in[13]; a.g_ffn = (const float*)d_in[14];
    a.w_router = (const float*)d_in[15]; a.router_bias = (const float*)d_in[16]; a.w_eg = (const float*)d_in[17]; a.w_eu = (const float*)d_in[18]; a.w_ed = (const float*)d_in[19];
    a.w_sg = (const float*)d_in[20]; a.w_su = (const float*)d_in[21]; a.w_sd = (const float*)d_in[22]; a.g_ple = (const float*)d_in[23]; a.w_pg = (const float*)d_in[24];
    a.w_pp = (const float*)d_in[25]; a.g_post = (const float*)d_in[26]; a.out = (float*)d_out; a.ws = (char*)d_ws;
    (void)hipMemsetAsync((char*)d_ws + C_BAR, 0, 16384, stream);
    void* args[] = {&a};
    hipError_t e = hipLaunchCooperativeKernel((const void*)mk_fwd, dim3(grid_blocks), dim3(NT), args, LDSB, stream);
    if (e != hipSuccess) fprintf(stderr, "cooperative launch failed: %s (grid %d)\n", hipGetErrorString(e), grid_blocks);
}
```
